# Optimizing an MI355X kernel written in HIP

```python
import jax, jax.numpy as jnp
from jax import lax
import numpy as np

D_MODEL = 1024
BATCH = 16
SEQ = 2048
DEPTH = 2

CHUNK = 64
D_MIX = D_MODEL
HG_WIDTH = D_MIX // 2
HG_EXPAND = 128
HG_HEADS = HG_WIDTH // HG_EXPAND
HG_DK = HG_EXPAND
HG_DV = HG_WIDTH // HG_HEADS
GM_WIDTH = D_MIX - HG_WIDTH
GM_HEADS = 4
GM_DH = GM_WIDTH // GM_HEADS
GM_BLOCK = 128
D_FF = 2816
N_MOD = 9
RMS_EPS = 1e-6
LN_EPS = 1e-5
IN_COLS = 4 * HG_WIDTH + 2 * GM_WIDTH

kernel_name = "hybrid_hgrn2_gmlp_macaron_adaln"


def rms_norm(x, gain, eps=RMS_EPS):
    xf = x.astype(jnp.float32)
    y = xf * lax.rsqrt(jnp.mean(xf * xf, axis=-1, keepdims=True) + eps)
    return (y * gain.astype(jnp.float32)).astype(x.dtype)


def modulate(x, shift, scale):
    return x * (1 + scale[:, None, :]) + shift[:, None, :]


def swiglu_ffn(x, w13, w2):
    a, b = jnp.split(x @ w13, 2, axis=-1)
    return (jax.nn.silu(a) * b) @ w2


def hgrn2_mixer(q, f_raw, i, g, lb, gnorm_gain):
    B, L, _ = q.shape
    nC = L // CHUNK
    dt = q.dtype
    lbf = lb.astype(jnp.float32)
    f = lbf + (1 - lbf) * jax.nn.sigmoid(f_raw.astype(jnp.float32))
    log_f = jnp.log(f)
    k = 1.0 - f

    def to_chunks(t, d):
        return t.astype(jnp.float32).reshape(B, nC, CHUNK, HG_HEADS, d).transpose(1, 0, 3, 2, 4)

    qc = to_chunks(q, HG_DK)
    kc = to_chunks(k, HG_DK)
    vc = to_chunks(i, HG_DV)
    bc = jnp.cumsum(to_chunks(log_f, HG_DK), axis=3)
    tri = jnp.tril(jnp.ones((CHUNK, CHUNK), dtype=bool))[:, :, None]

    def step(S, inp):
        qt, kt, vt, bt = inp
        diff = bt[:, :, :, None, :] - bt[:, :, None, :, :]
        decay = jnp.where(tri, jnp.exp(jnp.where(tri, diff, 0.0)), 0.0)
        A = jnp.einsum('bhtk,bhtsk,bhsk->bhts', qt, decay, kt)
        o = (jnp.einsum('bhts,bhsv->bhtv', A, vt)
             + jnp.einsum('bhtk,bhkv->bhtv', qt * jnp.exp(bt), S))
        b_last = bt[:, :, -1:, :]
        S = (jnp.exp(b_last[:, :, 0, :])[..., None] * S
             + jnp.einsum('bhsk,bhsv->bhkv', kt * jnp.exp(b_last - bt), vt))
        return S, o

    S0 = jnp.zeros((B, HG_HEADS, HG_DK, HG_DV), jnp.float32)
    _, o = lax.scan(step, S0, (qc, kc, vc, bc))
    o = o.transpose(1, 0, 3, 2, 4).reshape(B, L, HG_HEADS, HG_DV)
    o = rms_norm(o, gnorm_gain.reshape(HG_HEADS, HG_DV))
    o = o.reshape(B, L, HG_WIDTH) * jax.nn.silu(g.astype(jnp.float32))
    return o.astype(dt)


def gmlp_mixer(u, v, ln_gain, w_sp, b_sp, out_gain):
    B, L, _ = u.shape
    nB = L // GM_BLOCK
    dt = u.dtype
    u = jax.nn.gelu(u).reshape(B, nB, GM_BLOCK, GM_HEADS, GM_DH)
    v = jax.nn.gelu(v).reshape(B, nB, GM_BLOCK, GM_HEADS, GM_DH)
    vf = v.astype(jnp.float32)
    mu = jnp.mean(vf, axis=-1, keepdims=True)
    var = jnp.mean(jnp.square(vf - mu), axis=-1, keepdims=True)
    vn = ((vf - mu) * lax.rsqrt(var + LN_EPS) * ln_gain.reshape(GM_HEADS, GM_DH).astype(jnp.float32)).astype(dt)
    cpos = jnp.arange(GM_BLOCK) // CHUNK
    mask = cpos[:, None] >= cpos[None, :]
    w = jnp.where(mask[None], w_sp, 0.0)
    mixed = (jnp.einsum('hts,bnshd->bnthd', w, vn)
             + b_sp.T[None, None, :, :, None])
    y = rms_norm(u * mixed, out_gain.reshape(GM_HEADS, GM_DH))
    return y.reshape(B, L, GM_WIDTH)


def setup_inputs(seed: int = 0) -> dict:
    key = jax.random.key(seed)
    ks = jax.random.split(key, 18)

    def nrm(k, shape, scale):
        return scale * jax.random.normal(k, shape, jnp.float32)

    return {
        "x": nrm(ks[0], (BATCH, SEQ, D_MODEL), 1.0),
        "c": nrm(ks[1], (BATCH, D_MODEL), 1.0),
        "w_ada": nrm(ks[2], (DEPTH, D_MODEL, N_MOD * D_MODEL), 0.5 * D_MODEL ** -0.5),
        "b_ada": nrm(ks[3], (DEPTH, N_MOD * D_MODEL), 0.02),
        "norm_gain": 1.0 + nrm(ks[4], (DEPTH, 3, D_MODEL), 0.05),
        "ffn1_w13": nrm(ks[5], (DEPTH, D_MODEL, 2 * D_FF), D_MODEL ** -0.5),
        "ffn1_w2": nrm(ks[6], (DEPTH, D_FF, D_MODEL), D_FF ** -0.5),
        "w_in": nrm(ks[7], (DEPTH, D_MODEL, IN_COLS), D_MODEL ** -0.5),
        "hg_lb_logits": nrm(ks[8], (DEPTH, HG_WIDTH), 0.5),
        "hg_gnorm": 1.0 + nrm(ks[9], (DEPTH, HG_WIDTH), 0.05),
        "gm_ln_gain": 1.0 + nrm(ks[10], (DEPTH, GM_WIDTH), 0.05),
        "gm_w_spatial": nrm(ks[11], (DEPTH, GM_HEADS, GM_BLOCK, GM_BLOCK), 0.5 * GM_BLOCK ** -0.5),
        "gm_b_spatial": 1.0 + nrm(ks[12], (DEPTH, GM_HEADS, GM_BLOCK), 0.1),
        "gm_out_gain": 1.0 + nrm(ks[13], (DEPTH, GM_WIDTH), 0.05),
        "w_out": nrm(ks[14], (DEPTH, D_MIX, D_MODEL), D_MIX ** -0.5),
        "ffn2_w13": nrm(ks[15], (DEPTH, D_MODEL, 2 * D_FF), D_MODEL ** -0.5),
        "ffn2_w2": nrm(ks[16], (DEPTH, D_FF, D_MODEL), D_FF ** -0.5),
        "final_gain": 1.0 + nrm(ks[17], (D_MODEL,), 0.05),
    }


def reference(x, c, w_ada, b_ada, norm_gain, ffn1_w13, ffn1_w2, w_in, hg_lb_logits, hg_gnorm,
              gm_ln_gain, gm_w_spatial, gm_b_spatial, gm_out_gain, w_out, ffn2_w13, ffn2_w2,
              final_gain):
    B = x.shape[0]
    lb_all = jnp.cumsum(jax.nn.softmax(hg_lb_logits.astype(jnp.float32), axis=0), axis=0)
    lb_all = lb_all - lb_all[0]
    splits = [HG_WIDTH, 2 * HG_WIDTH, 3 * HG_WIDTH, 4 * HG_WIDTH, 4 * HG_WIDTH + GM_WIDTH]
    c_act = jax.nn.silu(c)
    h = x
    for l in range(DEPTH):
        mod = (c_act @ w_ada[l] + b_ada[l]).reshape(B, N_MOD, D_MODEL)
        sh1, sc1, g1 = mod[:, 0], mod[:, 1], mod[:, 2]
        sh2, sc2, g2 = mod[:, 3], mod[:, 4], mod[:, 5]
        sh3, sc3, g3 = mod[:, 6], mod[:, 7], mod[:, 8]

        y = modulate(rms_norm(h, norm_gain[l, 0]), sh1, sc1)
        h = h + 0.5 * g1[:, None, :] * swiglu_ffn(y, ffn1_w13[l], ffn1_w2[l])

        y = modulate(rms_norm(h, norm_gain[l, 1]), sh2, sc2)
        proj = y @ w_in[l]
        q, f_raw, i_in, g_out, u, v = jnp.split(proj, splits, axis=-1)
        o_hg = hgrn2_mixer(q, f_raw, i_in, g_out, lb_all[l], hg_gnorm[l])
        o_gm = gmlp_mixer(u, v, gm_ln_gain[l], gm_w_spatial[l], gm_b_spatial[l], gm_out_gain[l])
        mix = jnp.concatenate([o_hg, o_gm], axis=-1) @ w_out[l]
        h = h + g2[:, None, :] * mix

        y = modulate(rms_norm(h, norm_gain[l, 2]), sh3, sc3)
        h = h + 0.5 * g3[:, None, :] * swiglu_ffn(y, ffn2_w13[l], ffn2_w2[l])

    return rms_norm(h, final_gain)
```

```cpp
#include <hip/hip_runtime.h>
#include <cstdint>
namespace pg8 {
#define PG8_LAS __attribute__((address_space(3)))
typedef unsigned short bf16_t;
typedef short bf16x8 __attribute__((ext_vector_type(8)));
typedef float f32x4 __attribute__((ext_vector_type(4)));
typedef unsigned u32x4 __attribute__((ext_vector_type(4)));
constexpr int BM = 256, BK = 64, HALF = 128, HTB = HALF * BK * 2  , STAGE_BYTES = 8 * HTB, NXCD = 8, WGM = 8;

__host__ __device__ __forceinline__ int lds_byte(int r, int c) { const int st = (r >> 4) * 2 + (c >> 5), rr = r & 15, cc = c & 31, ob = rr * 64 + cc * 2; return st * 1024 + (ob ^ (((ob >> 9) & 1) << 5)); }
__host__ __device__ __forceinline__ void stage_rc(int b, int& R, int& C) { const int st = b / 1024, sb = b % 1024, swz = sb ^ (((sb >> 9) & 1) << 5); R = (st >> 1) * 16 + swz / 64; C = (st & 1) * 32 + (swz % 64) / 2; }
__host__ __device__ __forceinline__ int perm32(int rho) { const int n = rho >> 4, i = rho & 15; return 8 * (i >> 2) + 4 * n + (i & 3); }

struct Unit { int pm, pn; };
struct Gemm { const bf16_t* A; const bf16_t* Bt; int M, N, K; };

struct StaticOrder {
    int nM, nN, nwg, G, c;
    __host__ __device__ void init(int M, int N, int G_, int c_) { nM = M / BM; nN = N / BM; nwg = nM * nN; G = G_; c = c_; }
    __host__ __device__ bool next(int i, Unit& u) const {
        const long L = (long)i * G + c; if (L >= nwg) return false;
        int wgid = (int)L; { const int q = nwg / NXCD, r = nwg % NXCD, xcd = wgid % NXCD, off = wgid / NXCD; wgid = (xcd < r ? xcd * (q + 1) : r * (q + 1) + (xcd - r) * q) + off; }
        const int nig = WGM * nN, gid = wgid / nig, fm = gid * WGM, gsz = (nM - fm) < WGM ? (nM - fm) : WGM;
        u.pm = fm + ((wgid % nig) % gsz); u.pn = (wgid % nig) / gsz; return true;
    }
    __device__ __forceinline__ void a_ready(const Unit&) const {}
    __device__ __forceinline__ void done(const Unit&) const {}
};
__device__ __forceinline__ unsigned cvt_pk_bf16(float lo, float hi) { unsigned r; asm volatile("v_cvt_pk_bf16_f32 %0, %1, %2" : "=v"(r) : "v"(lo), "v"(hi)); return r; }
typedef unsigned u32x2 __attribute__((ext_vector_type(2)));
constexpr float RMS_EPS_F = 1e-6f;
constexpr int DM = 1024, DFF = 2816, NPROJ = 3072, MODLD = 9216, SEQL = 2048;
__device__ __forceinline__ float fast_rcp(float x) { return __builtin_amdgcn_rcpf(x); }
__device__ __forceinline__ float silu_f(float a) { return a * fast_rcp(1.0f + __expf(-a)); }
__device__ __forceinline__ float gelu_tanh_f(float x) {
    const float u2 = 1.5957691216057308f * (x + 0.044715f * x * x * x);
    return x * fast_rcp(1.0f + __expf(-u2));
}

struct EpiSwiglu {
    static constexpr bool PERM = true, AFTER_DRAIN = false;
    bf16_t* O; const unsigned long long* rowss; const float* shw;
    __device__ __forceinline__ void operator()(const f32x4 (&acc)[2][2][4][2], const Unit& u, int wr, int wc, int fr, int fq) const {
        const int row0 = u.pm * BM + wr * 64 + fr, bidx = (u.pm * BM) / SEQL;
        const float* sw = shw + (size_t)bidx * (2 * DFF) + u.pn * BM + wc * 32 + 8 * fq;
        f32x4 sa[2], sb[2];
#pragma unroll
        for (int n = 0; n < 2; ++n) { sa[n] = *(const f32x4*)(sw + 4 * n); sb[n] = *(const f32x4*)(sw + HALF + 4 * n); }
#pragma unroll
        for (int ai = 0; ai < 2; ++ai)
#pragma unroll
            for (int m = 0; m < 4; ++m) {
                const int row = row0 + ai * HALF + m * 16;
                const float rs = __builtin_amdgcn_rsqf((float)rowss[row] * (1.0f / (4294967296.0f * DM)) + RMS_EPS_F);
                float h[8];
#pragma unroll
                for (int n = 0; n < 2; ++n) {
                    const f32x4 va = acc[ai][0][m][n] * rs + sa[n], vb = acc[ai][1][m][n] * rs + sb[n];
#pragma unroll
                    for (int j = 0; j < 4; ++j) h[4 * n + j] = silu_f(va[j]) * vb[j];
                }
                u32x4 w; w.x = cvt_pk_bf16(h[0], h[1]); w.y = cvt_pk_bf16(h[2], h[3]); w.z = cvt_pk_bf16(h[4], h[5]); w.w = cvt_pk_bf16(h[6], h[7]);
                *(u32x4*)(O + (size_t)row * DFF + u.pn * HALF + wc * 32 + 8 * fq) = w;
            }
    }
};

struct EpiProj {
    static constexpr bool PERM = true, AFTER_DRAIN = false;
    bf16_t* O; const unsigned long long* rowss; const float* shw; const float* gnorm;
    __device__ __forceinline__ void operator()(const f32x4 (&acc)[2][2][4][2], const Unit& u, int wr, int wc, int fr, int fq) const {
        const int row0 = u.pm * BM + wr * 64 + fr, bidx = (u.pm * BM) / SEQL;
        const int col0 = u.pn * BM + wc * 32 + 8 * fq;
        const float* sw = shw + (size_t)bidx * NPROJ + col0;
        const int act = 0;
        f32x4 sv[2][2], gn[2][2];
#pragma unroll
        for (int bj = 0; bj < 2; ++bj)
#pragma unroll
            for (int n = 0; n < 2; ++n) { sv[bj][n] = *(const f32x4*)(sw + bj * HALF + 4 * n); gn[bj][n] = (act == 2) ? *(const f32x4*)(gnorm + (col0 - 1536) + bj * HALF + 4 * n) : (f32x4){1.f, 1.f, 1.f, 1.f}; }
#pragma unroll
        for (int ai = 0; ai < 2; ++ai)
#pragma unroll
            for (int m = 0; m < 4; ++m) {
                const int row = row0 + ai * HALF + m * 16;
                const float rs = __builtin_amdgcn_rsqf((float)rowss[row] * (1.0f / (4294967296.0f * DM)) + RMS_EPS_F);
#pragma unroll
                for (int bj = 0; bj < 2; ++bj) {
                    f32x4 v0 = acc[ai][bj][m][0] * rs + sv[bj][0], v1 = acc[ai][bj][m][1] * rs + sv[bj][1];
                    if (act == 1) {
#pragma unroll
                        for (int j = 0; j < 4; ++j) { v0[j] = gelu_tanh_f(v0[j]); v1[j] = gelu_tanh_f(v1[j]); }
                    } else if (act == 2) {
#pragma unroll
                        for (int j = 0; j < 4; ++j) { v0[j] = silu_f(v0[j]) * gn[bj][0][j]; v1[j] = silu_f(v1[j]) * gn[bj][1][j]; }
                    }
                    u32x4 w; w.x = cvt_pk_bf16(v0[0], v0[1]); w.y = cvt_pk_bf16(v0[2], v0[3]); w.z = cvt_pk_bf16(v1[0], v1[1]); w.w = cvt_pk_bf16(v1[2], v1[3]);
                    *(u32x4*)(O + (size_t)row * NPROJ + col0 + bj * HALF) = w;
                }
            }
    }
};

struct EpiResid {
    static constexpr bool PERM = true, AFTER_DRAIN = false;
    const float* basef; float* outf; bf16_t* hb; bf16_t* hs; const float* gate; const float* ngain; const float* nsc; unsigned long long* rowss_next; float gfac; int flags;
    template <bool BASE_F32> __device__ __forceinline__ void run(const f32x4 (&acc)[2][2][4][2], const Unit& u, int wr, int wc, int fr, int fq) const {
        const int row0 = u.pm * BM + wr * 64 + fr, bidx = (u.pm * BM) / SEQL;
        const int col0 = u.pn * BM + wc * 32 + 8 * fq;
        const bool out_f32 = !BASE_F32 && (flags & 2) != 0;
        f32x4 gv[2][2], nv[2][2];
#pragma unroll
        for (int bj = 0; bj < 2; ++bj)
#pragma unroll
            for (int n = 0; n < 2; ++n) {
                const int c = col0 + bj * HALF + 4 * n;
                gv[bj][n] = *(const f32x4*)(gate + (size_t)bidx * MODLD + c) * gfac;
                nv[bj][n] = *(const f32x4*)(ngain + c) * (*(const f32x4*)(nsc + (size_t)bidx * MODLD + c) + 1.0f);
            }
#pragma unroll
        for (int q4 = 0; q4 < 4; ++q4) {
            const int ai = q4 >> 1, m0 = 2 * (q4 & 1);
            f32x4 pre[2][2][2]; u32x4 raw[2][2];
#pragma unroll
            for (int mm = 0; mm < 2; ++mm) { const size_t off = (size_t)(row0 + ai * HALF + (m0 + mm) * 16) * DM + col0;
#pragma unroll
                for (int bj = 0; bj < 2; ++bj) {
                    if (BASE_F32) { pre[mm][bj][0] = *(const f32x4*)(basef + off + bj * HALF); pre[mm][bj][1] = *(const f32x4*)(basef + off + bj * HALF + 4); }
                    else raw[mm][bj] = *(const u32x4*)(hb + off + bj * HALF); } }
#pragma unroll
            for (int mm = 0; mm < 2; ++mm) {
                const int m = m0 + mm;
                const int row = row0 + ai * HALF + m * 16;
                const size_t off = (size_t)row * DM + col0;
                float ss = 0.f;
#pragma unroll
                for (int bj = 0; bj < 2; ++bj) {
                    f32x4 b0, b1;
                    if (BASE_F32) { b0 = pre[mm][bj][0]; b1 = pre[mm][bj][1]; }
                    else { const u32x4 r = raw[mm][bj];
                        b0 = (f32x4){__uint_as_float(r.x << 16), __uint_as_float(r.x & 0xffff0000u), __uint_as_float(r.y << 16), __uint_as_float(r.y & 0xffff0000u)};
                        b1 = (f32x4){__uint_as_float(r.z << 16), __uint_as_float(r.z & 0xffff0000u), __uint_as_float(r.w << 16), __uint_as_float(r.w & 0xffff0000u)}; }
                    const f32x4 o0 = b0 + gv[bj][0] * acc[ai][bj][m][0], o1 = b1 + gv[bj][1] * acc[ai][bj][m][1];
                    ss += (o0[0] * o0[0] + o0[1] * o0[1]) + (o0[2] * o0[2] + o0[3] * o0[3]) + (o1[0] * o1[0] + o1[1] * o1[1]) + (o1[2] * o1[2] + o1[3] * o1[3]);
                    u32x4 wb; wb.x = cvt_pk_bf16(o0[0], o0[1]); wb.y = cvt_pk_bf16(o0[2], o0[3]); wb.z = cvt_pk_bf16(o1[0], o1[1]); wb.w = cvt_pk_bf16(o1[2], o1[3]);
                    if (out_f32) { *(u32x4*)((bf16_t*)outf + off + bj * HALF) = wb; }
                    else {
                        *(u32x4*)(hb + off + bj * HALF) = wb;
                        const f32x4 s0 = o0 * nv[bj][0], s1 = o1 * nv[bj][1];
                        u32x4 w; w.x = cvt_pk_bf16(s0[0], s0[1]); w.y = cvt_pk_bf16(s0[2], s0[3]); w.z = cvt_pk_bf16(s1[0], s1[1]); w.w = cvt_pk_bf16(s1[2], s1[3]);
                        *(u32x4*)(hs + off + bj * HALF) = w;
                    }
                }
                ss += __shfl_xor(ss, 16); ss += __shfl_xor(ss, 32);
                if (fq == 0) atomicAdd(rowss_next + row, (unsigned long long)(ss * 4294967296.0f));
            }
        }
    }
    __device__ __forceinline__ void operator()(const f32x4 (&acc)[2][2][4][2], const Unit& u, int wr, int wc, int fr, int fq) const {
        if (flags & 1) run<true>(acc, u, wr, wc, fr, fq); else run<false>(acc, u, wr, wc, fr, fq);
    }
};

template <class T> __device__ __forceinline__ T* asg(unsigned long long v) {
    __attribute__((address_space(1))) T* g = (__attribute__((address_space(1))) T*)v; return (T*)g;
}
struct EpiAny {
    static constexpr bool PERM = true, AFTER_DRAIN = false;
    const PG8_LAS unsigned long long* et;
    __device__ __forceinline__ unsigned long long ld(int i) const {
        asm volatile("" ::: "memory");
        const unsigned long long v = et[i];
        const unsigned lo = __builtin_amdgcn_readfirstlane((unsigned)v), hi = __builtin_amdgcn_readfirstlane((unsigned)(v >> 32));
        return ((unsigned long long)hi << 32) | lo;
    }
    __device__ __forceinline__ void operator()(const f32x4 (&acc)[2][2][4][2], const Unit& u, int wr, int wc, int fr, int fq) const {
        const int mode = (int)ld(0);
        if (mode == 0) { EpiSwiglu e; e.O = asg<bf16_t>(ld(1)); e.rowss = asg<const unsigned long long>(ld(2)); e.shw = asg<const float>(ld(3)); e(acc, u, wr, wc, fr, fq); }
        else if (mode == 2) { EpiProj e; e.O = asg<bf16_t>(ld(1)); e.rowss = asg<const unsigned long long>(ld(2)); e.shw = asg<const float>(ld(3)); e.gnorm = asg<const float>(ld(4)); e(acc, u, wr, wc, fr, fq); }
        else if (mode == 9) { asm volatile("" :: "v"(acc[0][0][0][0]), "v"(acc[1][1][3][1]), "v"(acc[0][1][2][0]), "v"(acc[1][0][1][1])); }
        else { EpiResid e; e.basef = asg<const float>(ld(1)); e.outf = asg<float>(ld(2)); e.hs = asg<bf16_t>(ld(3)); e.gate = asg<const float>(ld(4)); e.ngain = asg<const float>(ld(5)); e.nsc = asg<const float>(ld(6));
               e.rowss_next = asg<unsigned long long>(ld(7)); e.gfac = __uint_as_float((unsigned)ld(8)); e.flags = (int)ld(9); e.hb = asg<bf16_t>(ld(10)); e(acc, u, wr, wc, fr, fq); }
    }
};
template <class Epi, class Sched, bool ALIGN_EPI = false, bool SP2 = false>
__device__ __forceinline__ void gemm_phase(PG8_LAS unsigned char* lds, const Gemm g, const Sched& S, const Epi& E) {
    int tid_o = threadIdx.x; asm volatile("" : "+v"(tid_o)); const int tid = tid_o, wid = __builtin_amdgcn_readfirstlane(tid >> 6), lane = tid & 63, wr = wid >> 2, wc = wid & 3, fr = lane & 15, fq = lane >> 4;
    const int K = g.K, nt = K / BK;
    unsigned voffA[2], voffB[2];
#pragma unroll
    for (int i = 0; i < 2; ++i) { int R, C; stage_rc(tid * 16 + i * 8192, R, C); const int Rb = Epi::PERM ? ((R & ~31) + perm32(R & 31)) : R;
        voffA[i] = (unsigned)(R * K + C) * 2u; voffB[i] = (unsigned)(Rb * K + C) * 2u; }
    const size_t kstep = (size_t)(BK * 2);
    const size_t hstep = (size_t)HALF * K * 2;
    const size_t tstep = 2 * hstep;
    const unsigned ldsw = (unsigned)wid * 1024u;
    const int aoff = lds_byte(wr * 64 + fr, fq * 8), boff = lds_byte(wc * 32 + fr, fq * 8);
#define PG8_SA(b, h) (((b) * 2 + (h)) * HTB)
#define PG8_SB(b, h) ((4 + (b) * 2 + (h)) * HTB)
#define PG8_STAGE(bufoff, gbase, voff) do { _Pragma("unroll") for (int _i = 0; _i < 2; ++_i) \
        __builtin_amdgcn_global_load_lds((const unsigned*)((const char*)(gbase) + (voff)[_i]), (PG8_LAS unsigned*)(lds + (bufoff) + ldsw + _i * 8192), 16, 0, 0); } while (0)
#define PG8_LDA(dst, b, h) do { _Pragma("unroll") for (int m = 0; m < 4; ++m) _Pragma("unroll") for (int k = 0; k < 2; ++k) dst[m][k] = *(const PG8_LAS bf16x8*)(lds + PG8_SA(b, h) + aoff + m * 2048 + k * 1024); } while (0)
#define PG8_LDB(dst, b, h) do { _Pragma("unroll") for (int n = 0; n < 2; ++n) _Pragma("unroll") for (int k = 0; k < 2; ++k) dst[n][k] = *(const PG8_LAS bf16x8*)(lds + PG8_SB(b, h) + boff + n * 2048 + k * 1024); } while (0)
#define PG8_MMA(ai, bj, At, Bt) do { __builtin_amdgcn_s_setprio(1); _Pragma("unroll") for (int m = 0; m < 4; ++m) _Pragma("unroll") for (int n = 0; n < 2; ++n) _Pragma("unroll") for (int k = 0; k < 2; ++k) \
        acc[ai][bj][m][n] = __builtin_amdgcn_mfma_f32_16x16x32_bf16(Bt[n][k], At[m][k], acc[ai][bj][m][n], 0, 0, 0); __builtin_amdgcn_s_setprio(0); } while (0)
#define PG8_WAIT_V(n) asm volatile("s_waitcnt vmcnt(" #n ")" ::: "memory")
#define PG8_WAIT_L(n) asm volatile("s_waitcnt lgkmcnt(" #n ")" ::: "memory")
#define PG8_BAR __builtin_amdgcn_s_barrier()
#define PG8_SCHED __builtin_amdgcn_sched_barrier(0)
    Unit cur, nxt; int ui = 0;
    if (!S.next(0, cur)) return;
    f32x4 acc[2][2][4][2];
#pragma unroll
    for (int a = 0; a < 2; ++a)
#pragma unroll
        for (int b = 0; b < 2; ++b)
#pragma unroll
            for (int m = 0; m < 4; ++m)
#pragma unroll
                for (int n = 0; n < 2; ++n) acc[a][b][m][n] = (f32x4){0.f, 0.f, 0.f, 0.f};
    bf16x8 At[4][2], B0[2][2], B1[2][2];
    const char* cA = (const char*)g.A + (size_t)cur.pm * tstep; const char* cB = (const char*)g.Bt + (size_t)cur.pn * tstep;
    S.a_ready(cur);
    if constexpr (SP2) {
        PG8_STAGE(PG8_SB(0, 0), cB, voffB); PG8_STAGE(PG8_SB(0, 1), cB + hstep, voffB); PG8_STAGE(PG8_SA(0, 0), cA, voffA); PG8_STAGE(PG8_SA(0, 1), cA + hstep, voffA);
        if (wr == 1) PG8_BAR;
        PG8_WAIT_V(2); PG8_BAR;
        PG8_STAGE(PG8_SB(1, 0), cB + kstep, voffB); PG8_STAGE(PG8_SA(1, 0), cA + kstep, voffA); PG8_STAGE(PG8_SB(1, 1), cB + hstep + kstep, voffB);
        PG8_WAIT_V(6); PG8_BAR;
    } else {
        PG8_STAGE(PG8_SB(0, 0), cB, voffB); PG8_STAGE(PG8_SA(0, 0), cA, voffA); PG8_STAGE(PG8_SB(0, 1), cB + hstep, voffB); PG8_STAGE(PG8_SA(0, 1), cA + hstep, voffA);
        if (wr == 1) PG8_BAR;
        PG8_WAIT_V(4); PG8_BAR;
        PG8_STAGE(PG8_SB(1, 0), cB + kstep, voffB); PG8_STAGE(PG8_SA(1, 0), cA + kstep, voffA); PG8_STAGE(PG8_SB(1, 1), cB + hstep + kstep, voffB);
        PG8_WAIT_V(6); PG8_BAR;
    }
    for (;;) {
        const bool has_next = S.next(ui + 1, nxt);
        const char* nA = has_next ? (const char*)g.A + (size_t)nxt.pm * tstep : cA; const char* nB = has_next ? (const char*)g.Bt + (size_t)nxt.pn * tstep : cB;
        for (int t = 0; t < nt; t += 2) {
            const bool last = (t == nt - 2);
            const char* a1 = cA + (size_t)(t + 1) * kstep;
            const char* a2 = last ? nA : cA + (size_t)(t + 2) * kstep; const char* b2 = last ? nB : cB + (size_t)(t + 2) * kstep;
            const char* a3 = a2 + kstep; const char* b3 = b2 + kstep;
            if (last && has_next) S.a_ready(nxt);
            if constexpr (SP2) {
            PG8_LDB(B0, 0, 0); PG8_LDB(B1, 0, 1); PG8_SCHED; PG8_LDA(At, 0, 0); PG8_STAGE(PG8_SA(1, 1), a1 + hstep, voffA);
            PG8_WAIT_V(8); PG8_WAIT_L(0); PG8_BAR; PG8_MMA(0, 0, At, B0); PG8_MMA(0, 1, At, B1); PG8_BAR; PG8_SCHED;
            PG8_LDA(At, 0, 1); PG8_STAGE(PG8_SB(0, 0), b2, voffB); PG8_STAGE(PG8_SB(0, 1), b2 + hstep, voffB); PG8_STAGE(PG8_SA(0, 0), a2, voffA);
            PG8_WAIT_V(8); PG8_WAIT_L(0); PG8_BAR; PG8_MMA(1, 0, At, B0); PG8_MMA(1, 1, At, B1); PG8_BAR; PG8_SCHED;
            PG8_LDB(B0, 1, 0); PG8_LDB(B1, 1, 1); PG8_SCHED; PG8_LDA(At, 1, 0); PG8_STAGE(PG8_SA(0, 1), a2 + hstep, voffA);
            PG8_WAIT_V(8); PG8_WAIT_L(0); PG8_BAR; PG8_MMA(0, 0, At, B0); PG8_MMA(0, 1, At, B1); PG8_BAR; PG8_SCHED;
            PG8_LDA(At, 1, 1); PG8_STAGE(PG8_SB(1, 0), b3, voffB); PG8_STAGE(PG8_SB(1, 1), b3 + hstep, voffB); PG8_STAGE(PG8_SA(1, 0), a3, voffA);
            PG8_WAIT_V(8); PG8_WAIT_L(0); PG8_BAR; PG8_MMA(1, 0, At, B0); PG8_MMA(1, 1, At, B1); PG8_BAR; PG8_SCHED;
            } else {
            PG8_LDB(B0, 0, 0); PG8_SCHED; PG8_LDA(At, 0, 0); PG8_STAGE(PG8_SA(1, 1), a1 + hstep, voffA);
            PG8_WAIT_L(8); PG8_BAR; PG8_WAIT_L(0); PG8_MMA(0, 0, At, B0); PG8_BAR; PG8_SCHED;
            PG8_LDB(B1, 0, 1); PG8_STAGE(PG8_SB(0, 0), b2, voffB);
            PG8_BAR; PG8_WAIT_L(0); PG8_MMA(0, 1, At, B1); PG8_BAR;
            PG8_LDA(At, 0, 1); PG8_STAGE(PG8_SA(0, 0), a2, voffA);
            PG8_BAR; PG8_WAIT_L(0); PG8_MMA(1, 0, At, B0); PG8_BAR; PG8_SCHED;
            PG8_STAGE(PG8_SB(0, 1), b2 + hstep, voffB);
            PG8_WAIT_V(6); PG8_BAR; PG8_MMA(1, 1, At, B1); PG8_BAR;
            PG8_LDB(B0, 1, 0); PG8_SCHED; PG8_LDA(At, 1, 0); PG8_STAGE(PG8_SA(0, 1), a2 + hstep, voffA);
            PG8_WAIT_L(8); PG8_BAR; PG8_WAIT_L(0); PG8_MMA(0, 0, At, B0); PG8_BAR; PG8_SCHED;
            PG8_LDB(B1, 1, 1); PG8_STAGE(PG8_SB(1, 0), b3, voffB);
            PG8_BAR; PG8_WAIT_L(0); PG8_MMA(0, 1, At, B1); PG8_BAR;
            PG8_LDA(At, 1, 1); PG8_STAGE(PG8_SA(1, 0), a3, voffA);
            PG8_BAR; PG8_WAIT_L(0); PG8_MMA(1, 0, At, B0); PG8_BAR; PG8_SCHED;
            PG8_STAGE(PG8_SB(1, 1), b3 + hstep, voffB);
            PG8_WAIT_V(6); PG8_BAR; PG8_MMA(1, 1, At, B1); PG8_BAR;
            }
        }
        if constexpr (ALIGN_EPI) { if (wr == 0) PG8_BAR; }
        if constexpr (!Epi::AFTER_DRAIN) { E(acc, cur, wr, wc, fr, fq); S.done(cur); }
        if (!has_next) break;
#pragma unroll
        for (int a = 0; a < 2; ++a)
#pragma unroll
            for (int b = 0; b < 2; ++b)
#pragma unroll
                for (int m = 0; m < 4; ++m)
#pragma unroll
                    for (int n = 0; n < 2; ++n) acc[a][b][m][n] = (f32x4){0.f, 0.f, 0.f, 0.f};
        cur = nxt; cA = nA; cB = nB; ++ui;
        if constexpr (ALIGN_EPI) { if (wr == 1) PG8_BAR; }
    }
    PG8_WAIT_V(0);
    if constexpr (!ALIGN_EPI) { if (wr == 0) PG8_BAR; }
    PG8_BAR;
    if constexpr (Epi::AFTER_DRAIN) { E.fused(acc, cur, wr, wc, fr, fq, lds, wid, lane); S.done(cur); }
#undef PG8_SA
#undef PG8_SB
#undef PG8_STAGE
#undef PG8_LDA
#undef PG8_LDB
#undef PG8_MMA
#undef PG8_WAIT_V
#undef PG8_WAIT_L
#undef PG8_BAR
#undef PG8_SCHED
}
}

#include <hip/hip_cooperative_groups.h>
#include <cstdio>
namespace cg = cooperative_groups;
using pg8::bf16_t; using pg8::bf16x8; using pg8::f32x4; using pg8::u32x4; using pg8::u32x2; using pg8::cvt_pk_bf16;
#define LAS __attribute__((address_space(3)))
constexpr int NWAVES = 8, NTHREADS = 512;
#ifndef REP_UP
#define REP_UP 1
#endif
#ifndef REP_SYNC
#define REP_SYNC 1
#endif
#ifndef REP_M1
#define REP_M1 1
#endif
#ifndef REP_SCAN
#define REP_SCAN 1
#endif
#ifndef REP_GMLP
#define REP_GMLP 1
#endif
#ifndef REP_WIN
#define REP_WIN 1
#endif
#ifndef REP_TAB
#define REP_TAB 1
#endif
#ifndef REP_MOD
#define REP_MOD 1
#endif
#ifndef PROBE_MODE
#define PROBE_MODE 1
#endif
#ifndef REP_DOWN
#define REP_DOWN 1
#endif
#ifndef REP_WOUT
#define REP_WOUT 1
#endif
#ifndef REP_MIX
#define REP_MIX 1
#endif
#ifndef REP_PRO
#define REP_PRO 1
#endif
constexpr int BATCH = 16, SEQ = 2048, D = 1024, M = BATCH * SEQ, FF = 2816, NP = 3072, NMOD = 9216, DEPTH = 2;
constexpr int LDS_BYTES = 147456;
constexpr size_t MiB = 1u << 20;
constexpr size_t WS_MODI = 0;
constexpr size_t WS_BAR = 2560 * 1024;
constexpr size_t WS_ROWSS = 3 * MiB;
constexpr size_t WS_ZERO_BYTES = 5 * MiB;
constexpr size_t WS_MOD = 5 * MiB;
constexpr float MOD_FX = 1099511627776.0f, ROWSS_FX = 4294967296.0f;
constexpr size_t WS_SHW = 6 * MiB + 256 * 1024;
constexpr int SHW_L = 16 * (2 * FF + NP + 2 * FF), SHW_O1 = 16 * 2 * FF, SHW_O2 = SHW_O1 + 16 * NP;
constexpr size_t WS_WSP = 90 * MiB;
constexpr size_t WS_W = 8 * MiB;
constexpr size_t W_13 = (size_t)2 * FF * D, W_2 = (size_t)D * FF, W_IN = (size_t)NP * D, W_OUT = (size_t)D * D;
constexpr size_t WL_13A = 0, WL_2A = WL_13A + W_13, WL_IN = WL_2A + W_2, WL_OUT = WL_IN + W_IN, WL_13B = WL_OUT + W_OUT, WL_2B = WL_13B + W_13, WL_TOTAL = WL_2B + W_2;
constexpr size_t WS_HS = 96 * MiB;
constexpr size_t WS_HF32 = 96 * MiB;
constexpr size_t WS_MIX = 160 * MiB;
constexpr size_t WS_R = 224 * MiB;
constexpr size_t WS_END = 416 * MiB;
static_assert(WS_W + 2 * WL_TOTAL * 2 <= WS_HS, "weights fit");
constexpr size_t HG_UNITS = 2048;
constexpr size_t WS_HQI = 416 * MiB;
constexpr size_t WS_HKS = 448 * MiB;
constexpr size_t WS_HVT = 480 * MiB;
constexpr size_t WS_HDK = 91 * MiB;
constexpr size_t WS_LB = 90 * MiB + 512 * 1024;
constexpr size_t WS_END2 = 512 * MiB;


__device__ __forceinline__ float bflo(unsigned u) { return __uint_as_float(u << 16); }
__device__ __forceinline__ float bfhi(unsigned u) { return __uint_as_float(u & 0xffff0000u); }
__device__ __forceinline__ unsigned f2bf(float f) { unsigned u = __builtin_bit_cast(unsigned, f); return (u + 0x7fffu + ((u >> 16) & 1u)) >> 16; }
__device__ __forceinline__ unsigned pk2(float lo, float hi) { return f2bf(lo) | (f2bf(hi) << 16); }
__device__ __forceinline__ float wave_sum(float v) {
#pragma unroll
    for (int o = 1; o < 64; o <<= 1) v += __shfl_xor(v, o);
    return v;
}
#define LDS_WAIT() asm volatile("s_waitcnt lgkmcnt(0)" ::: "memory")

#define RLX_AGENT __ATOMIC_RELAXED, __HIP_MEMORY_SCOPE_AGENT
#define XB_TMO      128
#define XB_XCNT(j)  (256  + 64 * (j))
#define XB_XSUB(j)  (1280 + 64 * (j))
#define XB_XGEN(j)  (2304 + 64 * (j))
#define XB_TOP      3328
#define XB_TOPGEN   3392
#define XCD_BAR_WORDS 3456
#define XB_SPIN_CAP (1u << 18)

__device__ __forceinline__ unsigned xb_ld(unsigned* p)              { return __hip_atomic_load(p, __ATOMIC_RELAXED, __HIP_MEMORY_SCOPE_AGENT); }
__device__ __forceinline__ unsigned xb_add(unsigned* p, unsigned v) { return __hip_atomic_fetch_add(p, v, __ATOMIC_RELAXED, __HIP_MEMORY_SCOPE_AGENT); }
__device__ __forceinline__ unsigned xb_xcc_id() { return (unsigned)__builtin_amdgcn_s_getreg((3 << 11) | 20) & 0xFu; }
#define XB_SPIN(cond, bar) do { unsigned _sp = 0; while (cond) { __builtin_amdgcn_s_sleep(1); \
    if ((++_sp & 255u) == 0u) { if (xb_ld(&(bar)[XB_TMO])) break; if (_sp > XB_SPIN_CAP) { atomicAdd(&(bar)[XB_TMO], 1u); break; } } } } while (0)

struct XcdBarrier {
    unsigned* bar; unsigned x;
    volatile LAS unsigned* st;
};

__device__ __forceinline__ XcdBarrier xcd_barrier_post(unsigned* bar, volatile LAS unsigned* st) {
    XcdBarrier b; b.bar = bar; b.x = xb_xcc_id(); b.st = st;
    if (threadIdx.x == 0) (void)xb_add(&bar[XB_XCNT(b.x)], 1u);
    return b;
}
__device__ __forceinline__ void xcd_barrier_complete(unsigned* bar, unsigned x, unsigned& nloc, unsigned& nx) {
    const unsigned G = gridDim.x * gridDim.y * gridDim.z;
    unsigned sum, cnt, mine, sp = 0u;
    for (;;) {
        sum = 0u; cnt = 0u; mine = 0u;
#pragma unroll
        for (unsigned j = 0; j < 16; ++j) { const unsigned c = xb_ld(&bar[XB_XCNT(j)]); sum += c; cnt += (c > 0u) ? 1u : 0u; mine = (j == x) ? c : mine; }
        if (sum == G) break;
        __builtin_amdgcn_s_sleep(1);
        if ((++sp & 255u) == 0u) { if (xb_ld(&bar[XB_TMO])) break; if (sp > XB_SPIN_CAP) { atomicAdd(&bar[XB_TMO], 1u); break; } }
    }
    nloc = mine > 0u ? mine : 1u; nx = cnt > 0u ? cnt : 1u;
}

__device__ __forceinline__ void xcd_barrier(const XcdBarrier& b) {
    asm volatile("s_waitcnt vmcnt(0)" ::: "memory");
    __syncthreads();
    if (threadIdx.x == 0) {
        unsigned* bar = b.bar;
        __builtin_amdgcn_s_waitcnt(0);
        unsigned nloc = b.st[0], nx = b.st[1];
        if (nloc == 0u) { xcd_barrier_complete(bar, b.x, nloc, nx); b.st[0] = nloc; b.st[1] = nx; }
        const unsigned old = xb_add(&bar[XB_XSUB(b.x)], 1u);
        const unsigned gen = old / nloc;
        if (old + 1u == (gen + 1u) * nloc) {
            __builtin_amdgcn_fence(__ATOMIC_RELEASE, "agent");
            asm volatile("s_waitcnt vmcnt(0)" ::: "memory");
            const unsigned og = xb_add(&bar[XB_TOP], 1u);
            const unsigned tg = og / nx;
            if (og + 1u == (tg + 1u) * nx) xb_add(&bar[XB_TOPGEN], 1u);
            else XB_SPIN(xb_ld(&bar[XB_TOPGEN]) == tg, bar);
            __builtin_amdgcn_fence(__ATOMIC_ACQUIRE, "agent");
            xb_add(&bar[XB_XGEN(b.x)], 1u);
            asm volatile("s_waitcnt vmcnt(0)" ::: "memory");
        } else {
            XB_SPIN(xb_ld(&bar[XB_XGEN(b.x)]) == gen, bar);
            __builtin_amdgcn_fence(__ATOMIC_ACQUIRE, "agent");
            asm volatile("s_waitcnt vmcnt(0)" ::: "memory");
        }
    }
    __syncthreads();
}

struct Args { const float* in[18]; float* out; unsigned char* ws; int ph_lo, ph_hi; };
constexpr int TAB_OFF = 139264, ET_OFF = TAB_OFF + 256, ST_OFF = TAB_OFF + 512;
typedef const LAS unsigned long long* ArgTab;
__device__ __forceinline__ bool tid0() { int t = threadIdx.x; asm volatile("" : "+v"(t)); return t == 0; }
__device__ __forceinline__ unsigned long long ldp(ArgTab tab, int i) {
    asm volatile("" ::: "memory");
    const unsigned long long v = tab[i];
    const unsigned lo = __builtin_amdgcn_readfirstlane((unsigned)v), hi = __builtin_amdgcn_readfirstlane((unsigned)(v >> 32));
    return ((unsigned long long)hi << 32) | lo;
}
template <class T> __device__ __forceinline__ T* as_global(unsigned long long v) {
    __attribute__((address_space(1))) T* g = (__attribute__((address_space(1))) T*)v;
    return (T*)g;
}
#define ARG_IN(i) (as_global<const float>(ldp(tab, (i))))
#define ARG_OUT() (as_global<float>(ldp(tab, 18)))
#define ARG_WS() (as_global<unsigned char>(ldp(tab, 19)))

__device__ __forceinline__ void transpose_item(const float* W, int K, int N, bf16_t* WT, int k0, int n0, int dst_row0, LAS float* scr, int lane) {
    float tv[32];
#pragma unroll
    for (int i = 0; i < 32; ++i) tv[i] = W[(size_t)(k0 + 2 * i + (lane >> 5)) * N + n0 + (lane & 31)];
#pragma unroll
    for (int i = 0; i < 32; ++i) scr[(2 * i + (lane >> 5)) * 33 + (lane & 31)] = tv[i];
    LDS_WAIT(); asm volatile("" ::: "memory");
    const int c = lane & 7;
#pragma unroll
    for (int j = 0; j < 4; ++j) { const int n = (lane >> 3) + 8 * j; const LAS float* s = scr + (8 * c) * 33 + n;
        u32x4 o; o.x = pk2(s[0 * 33], s[1 * 33]); o.y = pk2(s[2 * 33], s[3 * 33]); o.z = pk2(s[4 * 33], s[5 * 33]); o.w = pk2(s[6 * 33], s[7 * 33]);
        *(u32x4*)(WT + (size_t)(dst_row0 + n) * K + k0 + 8 * c) = o; }
    LDS_WAIT(); asm volatile("" ::: "memory");
}

__device__ __forceinline__ void convert_weights(ArgTab tab, LAS unsigned char* lds, int l, int gw, int NGW) {
    int tid_o = threadIdx.x; asm volatile("" : "+v"(tid_o)); const int tid = tid_o, lane = tid & 63, wave = __builtin_amdgcn_readfirstlane(tid >> 6);
    unsigned char* ws = ARG_WS();
    LAS float* scr = (LAS float*)(lds + 65536 + wave * 8448);
    constexpr int I13 = (D / 64) * (2 * FF / 32), I2 = (FF / 64) * (D / 32), IIN = (D / 64) * (NP / 32), IOUT = (D / 64) * (D / 32);
    constexpr int IL = 2 * I13 + 2 * I2 + IIN + IOUT;
    bf16_t* wl = (bf16_t*)(ws + WS_W) + (size_t)l * WL_TOTAL;
    for (int it = gw; it < IL; it += NGW) {
        int r = it;
        const float* src; int K, N; bf16_t* dst; bool is13 = false;
        if (r < I13) { src = ARG_IN(5) + (size_t)l * D * 2 * FF; K = D; N = 2 * FF; dst = wl + WL_13A; is13 = true; }
        else if ((r -= I13) < I2) { src = ARG_IN(6) + (size_t)l * FF * D; K = FF; N = D; dst = wl + WL_2A; }
        else if ((r -= I2) < IIN) { src = ARG_IN(7) + (size_t)l * D * NP; K = D; N = NP; dst = wl + WL_IN; }
        else if ((r -= IIN) < IOUT) { src = ARG_IN(14) + (size_t)l * D * D; K = D; N = D; dst = wl + WL_OUT; }
        else if ((r -= IOUT) < I13) { src = ARG_IN(15) + (size_t)l * D * 2 * FF; K = D; N = 2 * FF; dst = wl + WL_13B; is13 = true; }
        else { r -= I13; src = ARG_IN(16) + (size_t)l * FF * D; K = FF; N = D; dst = wl + WL_2B; }
        const int nblk = N / 32, kb = r / nblk, nb = r % nblk, k0 = 64 * kb, n0 = 32 * nb;
        int drow = n0;
        if (is13) { const int bj = n0 / FF, rr = n0 - bj * FF; drow = 256 * (rr / 128) + 128 * bj + (rr % 128); }
        transpose_item(src, K, N, dst, k0, n0, drow, scr, lane);
    }
}

__device__ __forceinline__ void shift_tables(ArgTab tab, int l, int gw, int NGW) {
    int tid_o = threadIdx.x; asm volatile("" : "+v"(tid_o)); const int tid = tid_o, lane = tid & 63, fr = lane & 15, fq = lane >> 4;
    unsigned char* ws = ARG_WS();
    const float* mod = (const float*)(ws + WS_MOD);
    constexpr int T13 = 2 * FF / 16, TIN = NP / 16, TL = 2 * T13 + TIN;
    for (int task = gw; task < TL; task += NGW) {
        int r = task;
        const bf16_t* wl = (const bf16_t*)(ws + WS_W) + (size_t)l * WL_TOTAL;
        float* shl = (float*)(ws + WS_SHW) + (size_t)l * SHW_L;
        const bf16_t* Bt; int N, sidx; float* dst;
        if (r < T13) { Bt = wl + WL_13A; N = 2 * FF; sidx = 0; dst = shl; }
        else if ((r -= T13) < TIN) { Bt = wl + WL_IN; N = NP; sidx = 3; dst = shl + SHW_O1; }
        else { r -= TIN; Bt = wl + WL_13B; N = 2 * FF; sidx = 6; dst = shl + SHW_O2; }
        const int n0 = r * 16;
        const float* ap = mod + ((size_t)l * 16 + fr) * NMOD + sidx * D + 8 * fq;
        const bf16_t* bp = Bt + (size_t)(n0 + fr) * D + 8 * fq;
        f32x4 acc = (f32x4){0.f, 0.f, 0.f, 0.f};
#pragma unroll 8
        for (int ks = 0; ks < 32; ++ks) {
            const f32x4 a0 = *(const f32x4*)(ap + ks * 32), a1 = *(const f32x4*)(ap + ks * 32 + 4);
            u32x4 aw; aw.x = cvt_pk_bf16(a0[0], a0[1]); aw.y = cvt_pk_bf16(a0[2], a0[3]); aw.z = cvt_pk_bf16(a1[0], a1[1]); aw.w = cvt_pk_bf16(a1[2], a1[3]);
            const bf16x8 af = __builtin_bit_cast(bf16x8, aw);
            const bf16x8 bf = *(const bf16x8*)(bp + ks * 32);
            acc = __builtin_amdgcn_mfma_f32_16x16x32_bf16(af, bf, acc, 0, 0, 0);
        }
#pragma unroll
        for (int j = 0; j < 4; ++j) dst[(size_t)(4 * fq + j) * N + n0 + fr] = acc[j];
    }
}

__device__ __forceinline__ void phase_prologue(ArgTab tab, LAS unsigned char* lds) {
    int tid_o = threadIdx.x; asm volatile("" : "+v"(tid_o)); const int tid = tid_o, lane = tid & 63, wave = __builtin_amdgcn_readfirstlane(tid >> 6);
    int bid_o = blockIdx.x; asm volatile("" : "+s"(bid_o)); const int G = gridDim.x, bid = bid_o;
    unsigned char* ws = ARG_WS();
    {
        LAS float* cact = (LAS float*)lds;
        const float* c = ARG_IN(1);
        for (int i = tid; i < 16 * 1024; i += NTHREADS) { const int b = i >> 10, k = i & 1023; const float v = c[i]; cact[k * 16 + b] = v / (1.0f + __expf(-v)); }
        __syncthreads();
        unsigned long long* modi = (unsigned long long*)(ws + WS_MODI);
        const float* w_ada = ARG_IN(2); const float* b_ada = ARG_IN(3);
        for (int rep_ = 0; rep_ < REP_MOD; ++rep_)
        for (int it = bid; it < 36 * 16; it += G) {
            const int cb = it % 36, kc = it / 36;
            const int ng = cb * 512 + tid, l = ng / NMOD, n = ng % NMOD;
            const float* wp = w_ada + ((size_t)l * D + kc * 64) * NMOD + n;
            float acc[16];
#pragma unroll
            for (int b = 0; b < 16; ++b) acc[b] = 0.f;
#pragma unroll 32
            for (int k = 0; k < 64; ++k) {
                const float w = wp[(size_t)k * NMOD];
                const LAS f32x4* cp = (const LAS f32x4*)(cact + (kc * 64 + k) * 16);
#pragma unroll
                for (int q = 0; q < 4; ++q) { const f32x4 cv = cp[q]; acc[4 * q + 0] += w * cv[0]; acc[4 * q + 1] += w * cv[1]; acc[4 * q + 2] += w * cv[2]; acc[4 * q + 3] += w * cv[3]; }
            }
            const float bias = (kc == 0) ? b_ada[l * NMOD + n] : 0.f;
#pragma unroll
            for (int b = 0; b < 16; ++b) atomicAdd(modi + ((size_t)l * 16 + b) * NMOD + n, (unsigned long long)(long long)((acc[b] + bias) * (MOD_FX / REP_MOD)));
        }
    }
    {
        convert_weights(tab, lds, 0, bid * NWAVES + wave, G * NWAVES);
        const float* wsp = ARG_IN(11); bf16_t* wspb = (bf16_t*)(ws + WS_WSP);
        for (int i = (bid * NTHREADS + tid) * 2; i < DEPTH * 4 * 128 * 128; i += G * NTHREADS * 2) *(unsigned*)(wspb + i) = pk2(wsp[i], wsp[i + 1]);
    }
}

__device__ __forceinline__ void phase_modconv(ArgTab tab) {
    int tid_o = threadIdx.x; asm volatile("" : "+v"(tid_o)); int bid_o = blockIdx.x; asm volatile("" : "+s"(bid_o));
    unsigned char* ws = ARG_WS();
    const long long* modi = (const long long*)(ws + WS_MODI); float* mod = (float*)(ws + WS_MOD);
    for (int i = bid_o * NTHREADS + tid_o; i < 2 * 16 * NMOD; i += (int)gridDim.x * NTHREADS) mod[i] = (float)modi[i] * (1.0f / MOD_FX);
}

__device__ __forceinline__ void phase_tables(ArgTab tab) {
    int tid_o = threadIdx.x; asm volatile("" : "+v"(tid_o)); const int tid = tid_o, lane = tid & 63, wave = __builtin_amdgcn_readfirstlane(tid >> 6), fr = lane & 15, fq = lane >> 4;
    int bid_o = blockIdx.x; asm volatile("" : "+s"(bid_o)); const int G = gridDim.x, gw = bid_o * NWAVES + wave, NGW = G * NWAVES;
    unsigned char* ws = ARG_WS();
    const float* mod = (const float*)(ws + WS_MOD);
    shift_tables(tab, 0, gw, NGW);
    {
        const float* lbl = ARG_IN(8); float* lb = (float*)(ws + WS_LB);
        if (bid_o == 0) for (int i = tid; i < 1024; i += NTHREADS) lb[i] = (i < 512) ? 0.f : 1.0f / (1.0f + __expf(lbl[i - 512] - lbl[i]));
    }
    {
        const float* x = ARG_IN(0); const float* gain = ARG_IN(4); bf16_t* hs = (bf16_t*)(ws + WS_HS); unsigned long long* rowss = (unsigned long long*)(ws + WS_ROWSS);
        for (int m0 = gw; m0 < M; m0 += 4 * NGW) {
            f32x4 v[4][4];
#pragma unroll
            for (int r = 0; r < 4; ++r) { const f32x4* xr = (const f32x4*)(x + (size_t)(m0 + r * NGW) * D) + lane;
#pragma unroll
                for (int j = 0; j < 4; ++j) v[r][j] = xr[64 * j]; }
#pragma unroll
            for (int r = 0; r < 4; ++r) {
                const int m = m0 + r * NGW, b = m / SEQ;
                const f32x4* gr = (const f32x4*)gain + lane;
                const f32x4* sr = (const f32x4*)(mod + (size_t)b * NMOD + 1 * D) + lane;
                float s = 0.f;
#pragma unroll
                for (int j = 0; j < 4; ++j) s += (v[r][j][0] * v[r][j][0] + v[r][j][1] * v[r][j][1]) + (v[r][j][2] * v[r][j][2] + v[r][j][3] * v[r][j][3]);
                s = wave_sum(s);
                if (lane == 0) rowss[m] = (unsigned long long)(s * ROWSS_FX);
                u32x2* o8 = (u32x2*)(hs + (size_t)m * D) + lane;
#pragma unroll
                for (int j = 0; j < 4; ++j) { const f32x4 sc = v[r][j] * (gr[64 * j] * (sr[64 * j] + 1.0f)); u32x2 w; w.x = cvt_pk_bf16(sc[0], sc[1]); w.y = cvt_pk_bf16(sc[2], sc[3]); o8[64 * j] = w; }
            }
        }
    }
}

__device__ __forceinline__ void phase_final(ArgTab tab) {
    int tid_o = threadIdx.x; asm volatile("" : "+v"(tid_o)); const int tid = tid_o, lane = tid & 63, wave = __builtin_amdgcn_readfirstlane(tid >> 6);
    int bid_o = blockIdx.x; asm volatile("" : "+s"(bid_o)); const int gw = bid_o * NWAVES + wave, NGW = gridDim.x * NWAVES;
    unsigned char* ws = ARG_WS();
    const unsigned long long* rowss = (const unsigned long long*)(ws + WS_ROWSS) + (size_t)6 * M; const float* fg = ARG_IN(17); float* outp = ARG_OUT(); const bf16_t* hf = (const bf16_t*)(ws + WS_HF32);
    for (int m0 = gw; m0 < M; m0 += 4 * NGW) {
        u32x2 rr[4][4];
#pragma unroll
        for (int r = 0; r < 4; ++r) { const u32x2* xr = (const u32x2*)(hf + (size_t)(m0 + r * NGW) * D) + lane;
#pragma unroll
            for (int j = 0; j < 4; ++j) rr[r][j] = xr[64 * j]; }
#pragma unroll
        for (int r = 0; r < 4; ++r) {
            const int m = m0 + r * NGW;
            const float rs = __builtin_amdgcn_rsqf((float)rowss[m] * (1.0f / (ROWSS_FX * D)) + 1e-6f);
            f32x4* orow = (f32x4*)(outp + (size_t)m * D) + lane; const f32x4* gr = (const f32x4*)fg + lane;
#pragma unroll
            for (int j = 0; j < 4; ++j) { const u32x2 q = rr[r][j]; orow[64 * j] = (f32x4){bflo(q.x), bfhi(q.x), bflo(q.y), bfhi(q.y)} * rs * gr[64 * j]; }
        }
    }
}

template <int CTRL> __device__ __forceinline__ float dpp_mul_shr(float p) {
    const int o = __builtin_amdgcn_update_dpp(__float_as_int(1.0f), __float_as_int(p), CTRL, 0xf, 0xf, false);
    return p * __int_as_float(o);
}
__device__ __forceinline__ float dpp_mul_bcast15(float p) {
    const int o = __builtin_amdgcn_update_dpp(__float_as_int(1.0f), __float_as_int(p), 0x142, 0xa, 0xf, false);
    return p * __int_as_float(o);
}
__device__ __forceinline__ float rdlane(float v, int l) { return __int_as_float(__builtin_amdgcn_readlane(__float_as_int(v), l)); }

__device__ __forceinline__ void hgrn_prep(LAS unsigned char* lds, const bf16_t* proj, unsigned char* ws, int layer, float* oi_base, bool st = true, int pm = 0) {
    int tid_o = threadIdx.x; asm volatile("" : "+v"(tid_o)); const int tid = tid_o, lane = tid & 63, wid = __builtin_amdgcn_readfirstlane(tid >> 6), fr = lane & 15, fq = lane >> 4;
    int bid_o = blockIdx.x; asm volatile("" : "+s"(bid_o)); const int bid = bid_o, G = gridDim.x;
    constexpr int QS = 136, TS = 72;
    LAS bf16_t* Q1 = (LAS bf16_t*)(lds);
    LAS bf16_t* Qi = (LAS bf16_t*)(lds + 8704);
    LAS bf16_t* Kd = (LAS bf16_t*)(lds + 26112);
    LAS bf16_t* KsT = (LAS bf16_t*)(lds + 43520);
    LAS bf16_t* vT = (LAS bf16_t*)(lds + 61952);
    LAS bf16_t* Am = (LAS bf16_t*)(lds + 80384);
    const float* lbt = (const float*)(ws + WS_LB) + layer * 512;
    u32x4 rq[2], rf[2], rv[2];
    {
        const int u = bid; const int seq = u >> 5, c = u & 31, b = seq >> 2, hd = seq & 3;
        if (u < (int)HG_UNITS) {
            const bf16_t* pq = proj + ((size_t)b * SEQ + c * 64 + lane) * NP + hd * 128 + 16 * wid;
            rq[0] = *(const u32x4*)(pq); rq[1] = *(const u32x4*)(pq + 8); rf[0] = *(const u32x4*)(pq + 512); rf[1] = *(const u32x4*)(pq + 520); rv[0] = *(const u32x4*)(pq + 1024); rv[1] = *(const u32x4*)(pq + 1032);
        }
    }
    for (int u = bid; u < (int)HG_UNITS; u += G) {
        const int seq = u >> 5, hd = seq & 3;
        bf16_t* gqi = (bf16_t*)(ws + WS_HQI) + (size_t)u * 8192;
        bf16_t* gks = (bf16_t*)(ws + WS_HKS) + (size_t)u * 8192;
        bf16_t* gvt = (bf16_t*)(ws + WS_HVT) + (size_t)u * 8192;
        float* goi = oi_base + (size_t)u * 8192;
        float* gdk = (float*)(ws + WS_HDK) + (size_t)u * 128;
        {
            float q[16], P[16], kk[16];
#pragma unroll
            for (int h2 = 0; h2 < 2; ++h2)
#pragma unroll
                for (int j = 0; j < 4; ++j) {
                    const unsigned uq = rq[h2][j], uf = rf[h2][j];
                    q[8 * h2 + 2 * j] = bflo(uq); q[8 * h2 + 2 * j + 1] = bfhi(uq);
                    P[8 * h2 + 2 * j] = bflo(uf); P[8 * h2 + 2 * j + 1] = bfhi(uf);
                }
            const float* lbp = lbt + hd * 128 + 16 * wid;
#pragma unroll
            for (int j = 0; j < 16; ++j) {
                const float x = fminf(fmaxf(P[j], -30.f), 30.f);
                const float e = __expf(-x), sg = pg8::fast_rcp(1.0f + e);
                const float lbj = lbp[j], om = 1.0f - lbj;
                P[j] = lbj + om * sg;
                kk[j] = om * e * sg;
            }
#pragma unroll
            for (int j = 0; j < 16; ++j) { float p = P[j]; p = dpp_mul_shr<0x111>(p); p = dpp_mul_shr<0x112>(p); p = dpp_mul_shr<0x114>(p); p = dpp_mul_shr<0x118>(p); p = dpp_mul_bcast15(p); P[j] = p; }
            unsigned wqi[8], wq1[8], wkd[8];
            float ks[16], dka[16];
            const bool lo = lane < 32;
#pragma unroll
            for (int j = 0; j < 16; j += 2) {
                float qi[2], q1[2], kd[2];
#pragma unroll
                for (int e2 = 0; e2 < 2; ++e2) {
                    const float H = P[j + e2];
                    const float h0 = rdlane(H, 31), h1 = rdlane(H, 63), dkv = h0 * h1;
                    const float rH = pg8::fast_rcp(fmaxf(H, 1e-37f)), qH = q[j + e2] * H, kr = kk[j + e2] * rH;
                    qi[e2] = lo ? qH : qH * h0;
                    q1[e2] = qH;
                    kd[e2] = kr;
                    ks[j + e2] = kr * (lo ? dkv : h1);
                    dka[j + e2] = dkv;
                }
                wqi[j >> 1] = cvt_pk_bf16(qi[0], qi[1]); wq1[j >> 1] = cvt_pk_bf16(q1[0], q1[1]); wkd[j >> 1] = cvt_pk_bf16(kd[0], kd[1]);
            }
            if (lane == 0 && st) {
#pragma unroll
                for (int j4 = 0; j4 < 4; ++j4) *(f32x4*)(gdk + 16 * wid + 4 * j4) = (f32x4){dka[4 * j4], dka[4 * j4 + 1], dka[4 * j4 + 2], dka[4 * j4 + 3]};
            }
            const u32x4 qa = (u32x4){wqi[0], wqi[1], wqi[2], wqi[3]}, qb = (u32x4){wqi[4], wqi[5], wqi[6], wqi[7]};
            *(LAS u32x4*)(Qi + lane * QS + 16 * wid) = qa; *(LAS u32x4*)(Qi + lane * QS + 16 * wid + 8) = qb;
            if (st) { *(u32x4*)(gqi + lane * 128 + 16 * wid) = qa; *(u32x4*)(gqi + lane * 128 + 16 * wid + 8) = qb; }
            if (lane >= 32) {
                *(LAS u32x4*)(Q1 + (lane - 32) * QS + 16 * wid) = (u32x4){wq1[0], wq1[1], wq1[2], wq1[3]};
                *(LAS u32x4*)(Q1 + (lane - 32) * QS + 16 * wid + 8) = (u32x4){wq1[4], wq1[5], wq1[6], wq1[7]};
            }
            *(LAS u32x4*)(Kd + lane * QS + 16 * wid) = (u32x4){wkd[0], wkd[1], wkd[2], wkd[3]};
            *(LAS u32x4*)(Kd + lane * QS + 16 * wid + 8) = (u32x4){wkd[4], wkd[5], wkd[6], wkd[7]};
            {
                const unsigned psel = (lane & 1) ? 0x03020706u : 0x05040100u;
                const int rsel = lane & 1, s2 = lane & ~1;
#pragma unroll
                for (int i = 0; i < 8; ++i) {
                    const unsigned pk = cvt_pk_bf16(ks[2 * i], ks[2 * i + 1]);
                    const unsigned pr = (unsigned)__builtin_amdgcn_mov_dpp((int)pk, 0xB1, 0xf, 0xf, true);
                    *(LAS unsigned*)(KsT + (16 * wid + 2 * i + rsel) * TS + s2) = __builtin_amdgcn_perm(pr, pk, psel);
                }
#pragma unroll
                for (int h2 = 0; h2 < 2; ++h2)
#pragma unroll
                    for (int j = 0; j < 4; ++j) {
                        const unsigned pk = rv[h2][j];
                        const unsigned pr = (unsigned)__builtin_amdgcn_mov_dpp((int)pk, 0xB1, 0xf, 0xf, true);
                        *(LAS unsigned*)(vT + (16 * wid + 8 * h2 + 2 * j + rsel) * TS + s2) = __builtin_amdgcn_perm(pr, pk, psel);
                    }
            }
        }
        {
            const int un = u + G;
            if (un < (int)HG_UNITS && pm != 4) {
                const int seqn = un >> 5, cn = un & 31, bn = seqn >> 2, hdn = seqn & 3;
                const bf16_t* pq = proj + ((size_t)bn * SEQ + cn * 64 + lane) * NP + hdn * 128 + 16 * wid;
                rq[0] = *(const u32x4*)(pq); rq[1] = *(const u32x4*)(pq + 8); rf[0] = *(const u32x4*)(pq + 512); rf[1] = *(const u32x4*)(pq + 520); rv[0] = *(const u32x4*)(pq + 1024); rv[1] = *(const u32x4*)(pq + 1032);
            }
        }
        __syncthreads();
        if (pm != 2) {
            const int ti = wid >> 1, tb = ti >> 1;
#pragma unroll
            for (int i = 0; i < 2; ++i) {
                const int sj = 2 * (wid & 1) + i, sb = sj >> 1;
                f32x4 sa = (f32x4){0.f, 0.f, 0.f, 0.f};
                if (tb >= sb) {
                    const LAS bf16_t* qa = (sb == 0) ? (Qi + (16 * ti + fr) * QS + 8 * fq) : (Q1 + (16 * ti - 32 + fr) * QS + 8 * fq);
                    const LAS bf16_t* kb = Kd + (16 * sj + fr) * QS + 8 * fq;
#pragma unroll
                    for (int ks2 = 0; ks2 < 4; ++ks2)
                        sa = __builtin_amdgcn_mfma_f32_16x16x32_bf16(*(const LAS bf16x8*)(qa + 32 * ks2), *(const LAS bf16x8*)(kb + 32 * ks2), sa, 0, 0, 0);
                }
                const int s = 16 * sj + fr;
#pragma unroll
                for (int r = 0; r < 4; ++r) { const int t = 16 * ti + 4 * fq + r; Am[t * TS + s] = (bf16_t)f2bf((s <= t) ? sa[r] : 0.f); }
            }
#pragma unroll
            for (int i = 0; i < 2; ++i) {
                const int ch = tid + 512 * i, row = ch >> 3, c8 = ch & 7;
                if (st) { *(u32x4*)(gks + row * 64 + 8 * c8) = *(const LAS u32x4*)(KsT + row * TS + 8 * c8);
                *(u32x4*)(gvt + row * 64 + 8 * c8) = *(const LAS u32x4*)(vT + row * TS + 8 * c8); }
            }
        }
        __syncthreads();
        if (pm != 2) {
            f32x4 o[4];
#pragma unroll
            for (int ti = 0; ti < 4; ++ti) o[ti] = (f32x4){0.f, 0.f, 0.f, 0.f};
#pragma unroll
            for (int ks2 = 0; ks2 < 2; ++ks2) {
                const bf16x8 bv = *(const LAS bf16x8*)(vT + (16 * wid + fr) * TS + 32 * ks2 + 8 * fq);
#pragma unroll
                for (int ti = 0; ti < 4; ++ti)
                    o[ti] = __builtin_amdgcn_mfma_f32_16x16x32_bf16(*(const LAS bf16x8*)(Am + (16 * ti + fr) * TS + 32 * ks2 + 8 * fq), bv, o[ti], 0, 0, 0);
            }
#pragma unroll
            for (int ti = 0; ti < 4; ++ti) { if (st) *(f32x4*)(goi + ((wid * 4 + ti) * 64 + lane) * 4) = o[ti]; else asm volatile("" :: "v"(o[ti])); }
        }
        __syncthreads();
    }
}

struct HgStage { u32x4 qi[2], ks[2], g[2]; bf16x8 vt[2]; f32x4 oi[4]; float dk; };
__device__ __forceinline__ void hgrn_scan(LAS unsigned char* lds, const bf16_t* proj, bf16_t* mix, unsigned char* ws, const float* gnorm, const float* oi_base, int seq, int pm = 0) {
    int tid_o = threadIdx.x; asm volatile("" : "+v"(tid_o)); const int tid = tid_o, lane = tid & 63, wid = __builtin_amdgcn_readfirstlane(tid >> 6), fr = lane & 15, fq = lane >> 4;
    const int b = seq >> 2, hd = seq & 3;
    constexpr int QS = 136, TS = 72, OS = 132;
    LAS bf16_t* Qi = (LAS bf16_t*)(lds);
    LAS bf16_t* KsT = (LAS bf16_t*)(lds + 17408);
    LAS bf16_t* ST = (LAS bf16_t*)(lds + 35840);
    LAS float*  Of = (LAS float*)(lds + 70656);
    LAS float*  dk = (LAS float*)(lds + 104448);
    for (int i = tid; i < 128 * QS / 2; i += NTHREADS) ((LAS unsigned*)ST)[i] = 0u;
    const int tq = tid >> 3, part = tid & 7;
    LAS float*  gns = (LAS float*)(lds + 105472);
    if (tid < 128) gns[tid] = gnorm[hd * 128 + tid];
    f32x4 S[8];
#pragma unroll
    for (int kt = 0; kt < 8; ++kt) S[kt] = (f32x4){0.f, 0.f, 0.f, 0.f};
    const size_t u0 = (size_t)seq * 32;
    const bf16_t* gqi = (const bf16_t*)(ws + WS_HQI) + u0 * 8192;
    const bf16_t* gks = (const bf16_t*)(ws + WS_HKS) + u0 * 8192;
    const bf16_t* gvt = (const bf16_t*)(ws + WS_HVT) + u0 * 8192;
    const float* goi = oi_base + u0 * 8192;
    const float* gdk = (const float*)(ws + WS_HDK) + u0 * 128;
    const bf16_t* pg = proj + ((size_t)b * SEQ + tq) * NP + 1536 + hd * 128 + 16 * part;
    const int ch0 = tid, ch1 = tid + 512;
    HgStage sA, sB; sA.dk = 0.f; sB.dk = 0.f;
#define HG_LOAD(st, c) do { const size_t uo = (size_t)(c); \
        st.qi[0] = *(const u32x4*)(gqi + uo * 8192 + ch0 * 8); st.qi[1] = *(const u32x4*)(gqi + uo * 8192 + ch1 * 8); \
        st.ks[0] = *(const u32x4*)(gks + uo * 8192 + ch0 * 8); st.ks[1] = *(const u32x4*)(gks + uo * 8192 + ch1 * 8); \
        st.vt[0] = *(const bf16x8*)(gvt + uo * 8192 + (16 * wid + fr) * 64 + 8 * fq); st.vt[1] = *(const bf16x8*)(gvt + uo * 8192 + (16 * wid + fr) * 64 + 32 + 8 * fq); \
        _Pragma("unroll") for (int ti = 0; ti < 4; ++ti) st.oi[ti] = *(const f32x4*)(goi + uo * 8192 + ((wid * 4 + ti) * 64 + lane) * 4); \
        if (tid < 128) st.dk = gdk[uo * 128 + tid]; \
        st.g[0] = *(const u32x4*)(pg + uo * 64 * NP); st.g[1] = *(const u32x4*)(pg + uo * 64 * NP + 8); } while (0)
#define HG_STEP(st, c) do { \
          \
        *(LAS u32x4*)(Qi + (ch0 >> 4) * QS + 8 * (ch0 & 15)) = st.qi[0]; *(LAS u32x4*)(Qi + (ch1 >> 4) * QS + 8 * (ch1 & 15)) = st.qi[1]; \
        *(LAS u32x4*)(KsT + (ch0 >> 3) * TS + 8 * (ch0 & 7)) = st.ks[0]; *(LAS u32x4*)(KsT + (ch1 >> 3) * TS + 8 * (ch1 & 7)) = st.ks[1]; \
        if (tid < 128) dk[((c) & 1) * 128 + tid] = st.dk; \
        f32x4 o[4]; bf16x8 bv[2]; u32x4 g[2]; \
        _Pragma("unroll") for (int ti = 0; ti < 4; ++ti) o[ti] = st.oi[ti]; \
        bv[0] = st.vt[0]; bv[1] = st.vt[1]; g[0] = st.g[0]; g[1] = st.g[1]; \
        if ((c) + 2 < 32 && pm != 2) HG_LOAD(st, (c) + 2); \
        __syncthreads(); \
          \
        if (pm != 3) { _Pragma("unroll") for (int ks2 = 0; ks2 < 4; ++ks2) { \
            const bf16x8 bs = *(const LAS bf16x8*)(ST + (16 * wid + fr) * QS + 32 * ks2 + 8 * fq); \
            _Pragma("unroll") for (int ti = 0; ti < 4; ++ti) \
                o[ti] = __builtin_amdgcn_mfma_f32_16x16x32_bf16(*(const LAS bf16x8*)(Qi + (16 * ti + fr) * QS + 32 * ks2 + 8 * fq), bs, o[ti], 0, 0, 0); \
        } \
        _Pragma("unroll") for (int kt = 0; kt < 8; ++kt) { const f32x4 dv = *(const LAS f32x4*)(dk + ((c) & 1) * 128 + 16 * kt + 4 * fq); S[kt] = S[kt] * dv; } \
        _Pragma("unroll") for (int ks2 = 0; ks2 < 2; ++ks2) \
            _Pragma("unroll") for (int kt = 0; kt < 8; ++kt) \
                S[kt] = __builtin_amdgcn_mfma_f32_16x16x32_bf16(*(const LAS bf16x8*)(KsT + (16 * kt + fr) * TS + 32 * ks2 + 8 * fq), bv[ks2], S[kt], 0, 0, 0); } \
        __syncthreads(); \
          \
        _Pragma("unroll") for (int ti = 0; ti < 4; ++ti) \
            _Pragma("unroll") for (int r = 0; r < 4; ++r) Of[(16 * ti + 4 * fq + r) * OS + 16 * wid + fr] = o[ti][r]; \
        _Pragma("unroll") for (int kt = 0; kt < 8; ++kt) { \
            u32x2 w2; w2.x = cvt_pk_bf16(S[kt][0], S[kt][1]); w2.y = cvt_pk_bf16(S[kt][2], S[kt][3]); \
            *(LAS u32x2*)(ST + (16 * wid + fr) * QS + 16 * kt + 4 * fq) = w2; \
        } \
        __syncthreads(); \
          \
        { \
            float ov[16]; float ss = 0.f; \
            _Pragma("unroll") for (int j4 = 0; j4 < 4; ++j4) { const f32x4 t4 = *(const LAS f32x4*)(Of + tq * OS + 16 * part + 4 * j4); ov[4 * j4] = t4[0]; ov[4 * j4 + 1] = t4[1]; ov[4 * j4 + 2] = t4[2]; ov[4 * j4 + 3] = t4[3]; \
                ss += (t4[0] * t4[0] + t4[1] * t4[1]) + (t4[2] * t4[2] + t4[3] * t4[3]); } \
            ss += __shfl_xor(ss, 1); ss += __shfl_xor(ss, 2); ss += __shfl_xor(ss, 4); \
            const float rs = __builtin_amdgcn_rsqf(ss * (1.0f / 128.0f) + 1e-6f); \
            unsigned w[8]; \
            _Pragma("unroll") for (int h2 = 0; h2 < 2; ++h2) \
                _Pragma("unroll") for (int j = 0; j < 4; ++j) { \
                    const unsigned ug = g[h2][j]; const float g0 = bflo(ug), g1 = bfhi(ug); const int e = 8 * h2 + 2 * j; \
                    w[4 * h2 + j] = cvt_pk_bf16(ov[e] * (rs * gns[16 * part + e] * pg8::silu_f(g0)), ov[e + 1] * (rs * gns[16 * part + e + 1] * pg8::silu_f(g1))); \
                } \
            bf16_t* po = mix + ((size_t)b * SEQ + (size_t)(c) * 64 + tq) * D + hd * 128 + 16 * part; \
            if (pm == 0) { *(u32x4*)(po) = (u32x4){w[0], w[1], w[2], w[3]}; *(u32x4*)(po + 8) = (u32x4){w[4], w[5], w[6], w[7]}; } else asm volatile("" :: "v"(w[0]), "v"(w[1]), "v"(w[2]), "v"(w[3]), "v"(w[4]), "v"(w[5]), "v"(w[6]), "v"(w[7])); \
        } \
          \
    } while (0)
    HG_LOAD(sA, 0); HG_LOAD(sB, 1);
    __syncthreads();
    for (int c = 0; c < 32; c += 2) { HG_STEP(sA, c); HG_STEP(sB, c + 1); }
#undef HG_LOAD
#undef HG_STEP
    __syncthreads();
}

__device__ __forceinline__ void gmlp_units(LAS unsigned char* lds, const bf16_t* proj, bf16_t* mix, const bf16_t* wspb, const float* lng, const float* bsp, const float* og, int u_first, int u_stride) {
    int tid_o = threadIdx.x; asm volatile("" : "+v"(tid_o)); const int tid = tid_o, lane = tid & 63, wid = __builtin_amdgcn_readfirstlane(tid >> 6), fr = lane & 15, fq = lane >> 4;
    constexpr int VS = 136;
    LAS bf16_t* vnT = (LAS bf16_t*)(lds);
    LAS bf16_t* Ug = (LAS bf16_t*)(lds + 34816);
    const int s = tid >> 2, p4 = tid & 3;
    u32x4 ru[4], rv[4];
    if (u_first < 1024) {
        const int hd = u_first & 3, nb = (u_first >> 2) & 15, b = u_first >> 6;
        const bf16_t* pu = proj + ((size_t)b * SEQ + nb * 128 + s) * NP + 2048 + hd * 128 + 32 * p4;
#pragma unroll
        for (int j = 0; j < 4; ++j) { ru[j] = *(const u32x4*)(pu + 8 * j); rv[j] = *(const u32x4*)(pu + 512 + 8 * j); }
    }
    for (int unit = u_first; unit < 1024; unit += u_stride) {
        const int hd = unit & 3, nb = (unit >> 2) & 15, b = unit >> 6;
        const size_t row0 = (size_t)b * SEQ + nb * 128;
        bf16x8 af[4];
        {
            const bf16_t* wa = wspb + ((size_t)hd * 128 + 16 * wid + fr) * 128 + 8 * fq;
#pragma unroll
            for (int ks = 0; ks < 4; ++ks) af[ks] = *(const bf16x8*)(wa + 32 * ks);
        }
        {
#pragma unroll
            for (int j = 0; j < 4; ++j) { u32x4 gu;
#pragma unroll
                for (int e = 0; e < 4; ++e) gu[e] = cvt_pk_bf16(pg8::gelu_tanh_f(bflo(ru[j][e])), pg8::gelu_tanh_f(bfhi(ru[j][e])));
                *(LAS u32x4*)(Ug + s * VS + 32 * p4 + 8 * j) = gu; }
            float v[32]; float sum = 0.f;
#pragma unroll
            for (int j = 0; j < 4; ++j)
#pragma unroll
                for (int e = 0; e < 4; ++e) { v[8 * j + 2 * e] = pg8::gelu_tanh_f(bflo(rv[j][e])); v[8 * j + 2 * e + 1] = pg8::gelu_tanh_f(bfhi(rv[j][e])); sum += v[8 * j + 2 * e] + v[8 * j + 2 * e + 1]; }
            {
                const int un = unit + u_stride;
                if (un < 1024) {
                    const int hdn = un & 3, nbn = (un >> 2) & 15, bn = un >> 6;
                    const bf16_t* pu = proj + ((size_t)bn * SEQ + nbn * 128 + s) * NP + 2048 + hdn * 128 + 32 * p4;
#pragma unroll
                    for (int j = 0; j < 4; ++j) { ru[j] = *(const u32x4*)(pu + 8 * j); rv[j] = *(const u32x4*)(pu + 512 + 8 * j); }
                }
            }
            sum += __shfl_xor(sum, 1); sum += __shfl_xor(sum, 2);
            const float mu = sum * (1.0f / 128.0f); float sq = 0.f;
#pragma unroll
            for (int j = 0; j < 32; ++j) { v[j] -= mu; sq += v[j] * v[j]; }
            sq += __shfl_xor(sq, 1); sq += __shfl_xor(sq, 2);
            const float rstd = __builtin_amdgcn_rsqf(sq * (1.0f / 128.0f) + 1e-5f);
            const float* lg = lng + hd * 128 + 32 * p4;
#pragma unroll
            for (int j = 0; j < 32; ++j) vnT[(32 * p4 + j) * VS + s] = (bf16_t)f2bf(v[j] * rstd * lg[j]);
        }
        __syncthreads();
        {
            f32x4 acc[8];
#pragma unroll
            for (int dt = 0; dt < 8; ++dt) acc[dt] = (f32x4){0.f, 0.f, 0.f, 0.f};
#pragma unroll
            for (int ks = 0; ks < 4; ++ks) {
                if (ks < 2 || wid >= 4) {
#pragma unroll
                    for (int dt = 0; dt < 8; ++dt)
                        acc[dt] = __builtin_amdgcn_mfma_f32_16x16x32_bf16(af[ks], *(const LAS bf16x8*)(vnT + (16 * dt + fr) * VS + 32 * ks + 8 * fq), acc[dt], 0, 0, 0);
                }
            }
            float bs[4], ss[4];
#pragma unroll
            for (int r = 0; r < 4; ++r) { bs[r] = bsp[hd * 128 + 16 * wid + 4 * fq + r]; ss[r] = 0.f; }
#pragma unroll
            for (int dt = 0; dt < 8; ++dt)
#pragma unroll
                for (int r = 0; r < 4; ++r) {
                    const float uval = __uint_as_float((unsigned)Ug[(16 * wid + 4 * fq + r) * VS + 16 * dt + fr] << 16);
                    const float y = uval * (acc[dt][r] + bs[r]); acc[dt][r] = y; ss[r] += y * y;
                }
#pragma unroll
            for (int r = 0; r < 4; ++r) { float s2 = ss[r]; s2 += __shfl_xor(s2, 1); s2 += __shfl_xor(s2, 2); s2 += __shfl_xor(s2, 4); s2 += __shfl_xor(s2, 8); ss[r] = __builtin_amdgcn_rsqf(s2 * (1.0f / 128.0f) + 1e-6f); }
#pragma unroll
            for (int dt = 0; dt < 8; ++dt) { const float gq = og[hd * 128 + 16 * dt + fr];
#pragma unroll
                for (int r = 0; r < 4; ++r) Ug[(16 * wid + 4 * fq + r) * VS + 16 * dt + fr] = (bf16_t)f2bf(acc[dt][r] * ss[r] * gq); }
        }
        __syncthreads();
        {
            bf16_t* po = mix + (row0 + s) * D + 512 + hd * 128 + 32 * p4;
#pragma unroll
            for (int j = 0; j < 4; ++j) *(u32x4*)(po + 8 * j) = *(const LAS u32x4*)(Ug + s * VS + 32 * p4 + 8 * j);
        }
        __syncthreads();
    }
}

constexpr int N_PHASES = 20;
__global__ void __launch_bounds__(NTHREADS, 2) fwd_megakernel(Args args) {
    extern __shared__ __attribute__((aligned(16))) unsigned char lds_raw[];
    LAS unsigned char* lds = (LAS unsigned char*)lds_raw;
    cg::grid_group grid = cg::this_grid();
    {
        const __attribute__((address_space(4))) unsigned long long* ka = (const __attribute__((address_space(4))) unsigned long long*)__builtin_amdgcn_kernarg_segment_ptr();
        if (threadIdx.x < 20) ((LAS unsigned long long*)(lds + TAB_OFF))[threadIdx.x] = ka[threadIdx.x];
        if (threadIdx.x < 4) ((LAS unsigned*)(lds + ST_OFF))[threadIdx.x] = 0u;
        __syncthreads();
    }
    ArgTab tab = (ArgTab)(lds + TAB_OFF);
    const XcdBarrier xbar = xcd_barrier_post((unsigned*)(args.ws + WS_BAR), (volatile LAS unsigned*)(lds + ST_OFF));
    const int G = gridDim.x;
    for (int ph = args.ph_lo; ph < args.ph_hi; ++ph) {
#ifndef DIS_PRO
        if (ph == 0) phase_prologue(tab, lds);
        else
#endif
#ifndef DIS_TAB
        if (ph == 1) phase_modconv(tab);
        else if (ph == 2) for (int rep_ = 0; rep_ < REP_TAB; ++rep_) phase_tables(tab);
        else
#endif
        if (ph < 3) {}
        else if (ph == N_PHASES - 1) phase_final(tab);
        else {
            const int l = (ph - 3) / 8, p8 = (ph - 3) % 8, s = (p8 <= 3) ? p8 : (p8 == 4 ? 7 : p8 - 1);
            unsigned char* ws = ARG_WS();
            float* mod = (float*)(ws + WS_MOD);
            unsigned long long* rowss = (unsigned long long*)(ws + WS_ROWSS);
            bf16_t* hs = (bf16_t*)(ws + WS_HS);
            bf16_t* mix = (bf16_t*)(ws + WS_MIX);
            bf16_t* R = (bf16_t*)(ws + WS_R);
            const bf16_t* wl = (const bf16_t*)(ws + WS_W) + (size_t)l * WL_TOTAL;
            const float* shl = (const float*)(ws + WS_SHW) + (size_t)l * SHW_L;
            const float* modl = mod + (size_t)l * 16 * NMOD;
#ifndef DIS_GEMM
            if (s != 3 && s != 7) {
                LAS unsigned long long* et = (LAS unsigned long long*)(lds + ET_OFF);
                const bf16_t* A; const bf16_t* Bt; int N, K;
                if (s == 0 || s == 5) {
                    A = hs; Bt = wl + (s == 0 ? WL_13A : WL_13B); N = 2 * FF; K = D;
                    if (tid0()) { et[0] = 0ull; et[1] = (unsigned long long)R; et[2] = (unsigned long long)(rowss + (size_t)(3 * l + (s == 0 ? 0 : 2)) * M); et[3] = (unsigned long long)(shl + (s == 0 ? 0 : SHW_O2)); }
                } else if (s == 2) {
                    A = hs; Bt = wl + WL_IN; N = NP; K = D;
                    if (tid0()) { et[0] = 2ull; et[1] = (unsigned long long)R; et[2] = (unsigned long long)(rowss + (size_t)(3 * l + 1) * M); et[3] = (unsigned long long)(shl + SHW_O1); et[4] = (unsigned long long)(ARG_IN(9) + l * 512); }
                } else {
                    const int sub = (s == 1) ? 0 : (s == 4 ? 1 : 2);
                    const int nl = (sub == 2) ? l + 1 : l, nsub = (sub + 1) % 3;
                    const bool last = (nl == DEPTH);
                    A = (s == 4) ? mix : R; Bt = wl + (s == 1 ? WL_2A : (s == 4 ? WL_OUT : WL_2B)); N = D; K = (s == 4) ? D : FF;
                    if (l == 0 && s == 4) { int bo = blockIdx.x; asm volatile("" : "+s"(bo)); const int wv = __builtin_amdgcn_readfirstlane((int)(threadIdx.x >> 6)); shift_tables(tab, 1, bo * NWAVES + wv, G * NWAVES); }
                    if (tid0()) {
                        const float* gains = ARG_IN(4);
                        float* outp = ARG_OUT();
                        const bool first = (l == 0 && s == 1);
                        et[0] = 1ull; et[1] = (unsigned long long)ARG_IN(0); et[2] = (unsigned long long)(ws + WS_HF32); et[3] = (unsigned long long)hs;
                        et[4] = (unsigned long long)(modl + (3 * sub + 2) * D);
                        et[5] = (unsigned long long)(gains + (size_t)(3 * (last ? 0 : nl) + nsub) * D); et[6] = (unsigned long long)(mod + (size_t)(last ? 0 : nl) * 16 * NMOD + (3 * nsub + 1) * D);
                        et[7] = (unsigned long long)(rowss + (size_t)(3 * l + sub + 1) * M); et[8] = (unsigned long long)__float_as_uint((s == 4) ? 1.0f : 0.5f); et[9] = (first ? 1ull : 0ull) | (last ? 2ull : 0ull);
                        et[10] = (unsigned long long)(outp + (size_t)M * D / 2);
                    }
                }
                __syncthreads();
                pg8::Gemm g{A, Bt, M, N, K}; pg8::StaticOrder S; int bid_o = blockIdx.x; asm volatile("" : "+s"(bid_o)); S.init(M, N, G, bid_o);
                pg8::EpiAny E{(const LAS unsigned long long*)et};
                const int nrep_ = (s == 0 || s == 5) ? REP_UP : (s == 2 ? REP_WIN : ((s == 1 || s == 6) ? REP_DOWN : REP_WOUT));
                for (int rep_ = 0; rep_ < nrep_; ++rep_) {
                    if ((s == 1 || s == 4 || s == 6) && nrep_ > 1) { __syncthreads(); if (tid0()) { if (rep_ + 1 < nrep_) { et[20] = et[7]; et[21] = et[8]; et[7] = (unsigned long long)(ws + 3 * MiB); et[8] = 0ull; if (PROBE_MODE == 9) et[0] = 9ull; } else { et[7] = et[20]; et[8] = et[21]; et[0] = 1ull; } } __syncthreads(); }
                    pg8::gemm_phase<pg8::EpiAny, pg8::StaticOrder, true, true>(lds, g, S, E);
                }
            } else
#endif
            if (s == 3) {
#ifndef DIS_HGRN
                for (int rep_ = 0; rep_ < REP_M1; ++rep_) hgrn_prep(lds, R, ws, l, ARG_OUT(), rep_ == 0, rep_ == 0 ? 0 : PROBE_MODE);
#endif
            } else if (s == 7) {
                int bid_o = blockIdx.x; asm volatile("" : "+s"(bid_o)); const int bid = bid_o;
                const int nh = 64;
#ifndef DIS_HGRN
                if (bid < nh) for (int rep_ = 0; rep_ < REP_SCAN; ++rep_) hgrn_scan(lds, R, mix, ws, ARG_IN(9) + l * 512, ARG_OUT(), bid, rep_ == 0 ? 0 : PROBE_MODE);
                else
#endif
                {
                    const bf16_t* wspb = (const bf16_t*)(ws + WS_WSP) + (size_t)l * 4 * 128 * 128;
#ifndef DIS_GMLP
                    for (int rep_ = 0; rep_ < REP_GMLP; ++rep_)
                    gmlp_units(lds, R, mix, wspb, ARG_IN(10) + l * 512, ARG_IN(12) + l * 512, ARG_IN(13) + l * 512, bid - nh, G - nh);
#endif
                    if (l == 0) { const int wv = __builtin_amdgcn_readfirstlane((int)(threadIdx.x >> 6)); convert_weights(tab, lds, 1, (bid - nh) * NWAVES + wv, (G - nh) * NWAVES); }
                }
            }
        }
        if (ph + 1 < args.ph_hi) { if (args.ph_hi > N_PHASES) grid.sync(); else xcd_barrier(xbar); }
    }
}

#ifndef MK_PER_PHASE_LAUNCH
#define MK_PER_PHASE_LAUNCH 0
#endif
extern "C" void kernel_launch(void* const* d_in, const int* in_sizes, int n_in, void* d_out, int out_size, void* d_ws, size_t ws_size, hipStream_t stream) {
    static int grid = 0;
    if (grid == 0) {
        if (n_in != 18 || in_sizes[0] != M * D || out_size != M * D || ws_size < WS_END2) { fprintf(stderr, "kernel_launch: unexpected shapes (n_in %d, in0 %d, out %d, ws %zu)\n", n_in, n_in > 0 ? in_sizes[0] : -1, out_size, ws_size); grid = -1; return; }
        int dev = 0, cus = 0, per_cu = 0;
        hipGetDevice(&dev); hipDeviceGetAttribute(&cus, hipDeviceAttributeMultiprocessorCount, dev);
        if (hipFuncSetAttribute((const void*)fwd_megakernel, hipFuncAttributeMaxDynamicSharedMemorySize, LDS_BYTES) != hipSuccess) { fprintf(stderr, "kernel_launch: hipFuncSetAttribute failed\n"); grid = -1; return; }
        hipOccupancyMaxActiveBlocksPerMultiprocessor(&per_cu, (const void*)fwd_megakernel, NTHREADS, LDS_BYTES);
        (void)hipGetLastError();
        if (per_cu < 1) fprintf(stderr, "kernel_launch: occupancy query says %d blocks per CU\n", per_cu);
        grid = cus;
    }
    if (grid < 0) return;
    hipMemsetAsync((char*)d_ws, 0, WS_ZERO_BYTES, stream);
    Args a{};
    for (int i = 0; i < 18; ++i) a.in[i] = (const float*)d_in[i];
    a.out = (float*)d_out; a.ws = (unsigned char*)d_ws;
#if MK_PER_PHASE_LAUNCH
    for (int ph = 0; ph < N_PHASES; ++ph) { a.ph_lo = ph; a.ph_hi = ph + 1; hipLaunchKernelGGL(fwd_megakernel, dim3(grid), dim3(NTHREADS), LDS_BYTES, stream, a); }
#else
    a.ph_lo = 0; a.ph_hi = N_PHASES;
    void* kargs[] = {&a};
    hipError_t e = hipLaunchCooperativeKernel((const void*)fwd_megakernel, dim3(grid), dim3(NTHREADS), kargs, LDS_BYTES, stream);
    if (e != hipSuccess) fprintf(stderr, "cooperative launch failed: %s (grid %d)\n", hipGetErrorString(e), grid);
#endif
}
```

```cpp
#include <hip/hip_runtime.h>
#include <cstdint>
namespace pg8 {
#define PG8_LAS __attribute__((address_space(3)))
typedef unsigned short bf16_t;
typedef short bf16x8 __attribute__((ext_vector_type(8)));
typedef float f32x4 __attribute__((ext_vector_type(4)));
typedef unsigned u32x4 __attribute__((ext_vector_type(4)));
constexpr int BM = 256, BK = 64, HALF = 128, HTB = HALF * BK * 2  , STAGE_BYTES = 8 * HTB, NXCD = 8, WGM = 8;

__host__ __device__ __forceinline__ int lds_byte(int r, int c) { const int st = (r >> 4) * 2 + (c >> 5), rr = r & 15, cc = c & 31, ob = rr * 64 + cc * 2; return st * 1024 + (ob ^ (((ob >> 9) & 1) << 5)); }
__host__ __device__ __forceinline__ void stage_rc(int b, int& R, int& C) { const int st = b / 1024, sb = b % 1024, swz = sb ^ (((sb >> 9) & 1) << 5); R = (st >> 1) * 16 + swz / 64; C = (st & 1) * 32 + (swz % 64) / 2; }
__host__ __device__ __forceinline__ int perm32(int rho) { const int n = rho >> 4, i = rho & 15; return 8 * (i >> 2) + 4 * n + (i & 3); }

struct Unit { int pm, pn; };
struct Gemm { const bf16_t* A; const bf16_t* Bt; int M, N, K; };

struct StaticOrder {
    int nM, nN, nwg, G, c;
    __host__ __device__ void init(int M, int N, int G_, int c_) { nM = M / BM; nN = N / BM; nwg = nM * nN; G = G_; c = c_; }
    __host__ __device__ bool next(int i, Unit& u) const {
        const long L = (long)i * G + c; if (L >= nwg) return false;
        int wgid = (int)L; { const int q = nwg / NXCD, r = nwg % NXCD, xcd = wgid % NXCD, off = wgid / NXCD; wgid = (xcd < r ? xcd * (q + 1) : r * (q + 1) + (xcd - r) * q) + off; }
        const int nig = WGM * nN, gid = wgid / nig, fm = gid * WGM, gsz = (nM - fm) < WGM ? (nM - fm) : WGM;
        u.pm = fm + ((wgid % nig) % gsz); u.pn = (wgid % nig) / gsz; return true;
    }
    __device__ __forceinline__ void a_ready(const Unit&) const {}
    __device__ __forceinline__ void done(const Unit&) const {}
};
__device__ __forceinline__ unsigned cvt_pk_bf16(float lo, float hi) { unsigned r; asm volatile("v_cvt_pk_bf16_f32 %0, %1, %2" : "=v"(r) : "v"(lo), "v"(hi)); return r; }
typedef unsigned u32x2 __attribute__((ext_vector_type(2)));
constexpr float RMS_EPS_F = 1e-6f;
constexpr int DM = 1024, DFF = 2816, NPROJ = 3072, MODLD = 9216, SEQL = 2048;
__device__ __forceinline__ float fast_rcp(float x) { return __builtin_amdgcn_rcpf(x); }
__device__ __forceinline__ float silu_f(float a) { return a * fast_rcp(1.0f + __expf(-a)); }
__device__ __forceinline__ float gelu_tanh_f(float x) {
    const float u2 = 1.5957691216057308f * (x + 0.044715f * x * x * x);
    return x * fast_rcp(1.0f + __expf(-u2));
}

struct EpiSwiglu {
    static constexpr bool PERM = true, AFTER_DRAIN = false;
    bf16_t* O; const unsigned long long* rowss; const float* shw;
    __device__ __forceinline__ void operator()(const f32x4 (&acc)[2][2][4][2], const Unit& u, int wr, int wc, int fr, int fq) const {
        const int row0 = u.pm * BM + wr * 64 + fr, bidx = (u.pm * BM) / SEQL;
        const float* sw = shw + (size_t)bidx * (2 * DFF) + u.pn * BM + wc * 32 + 8 * fq;
        f32x4 sa[2], sb[2];
#pragma unroll
        for (int n = 0; n < 2; ++n) { sa[n] = *(const f32x4*)(sw + 4 * n); sb[n] = *(const f32x4*)(sw + HALF + 4 * n); }
#pragma unroll
        for (int ai = 0; ai < 2; ++ai)
#pragma unroll
            for (int m = 0; m < 4; ++m) {
                const int row = row0 + ai * HALF + m * 16;
                const float rs = __builtin_amdgcn_rsqf((float)rowss[row] * (1.0f / (4294967296.0f * DM)) + RMS_EPS_F);
                float h[8];
#pragma unroll
                for (int n = 0; n < 2; ++n) {
                    const f32x4 va = acc[ai][0][m][n] * rs + sa[n], vb = acc[ai][1][m][n] * rs + sb[n];
#pragma unroll
                    for (int j = 0; j < 4; ++j) h[4 * n + j] = silu_f(va[j]) * vb[j];
                }
                u32x4 w; w.x = cvt_pk_bf16(h[0], h[1]); w.y = cvt_pk_bf16(h[2], h[3]); w.z = cvt_pk_bf16(h[4], h[5]); w.w = cvt_pk_bf16(h[6], h[7]);
                *(u32x4*)(O + (size_t)row * DFF + u.pn * HALF + wc * 32 + 8 * fq) = w;
            }
    }
};

struct EpiProj {
    static constexpr bool PERM = true, AFTER_DRAIN = false;
    bf16_t* O; const unsigned long long* rowss; const float* shw; const float* gnorm;
    __device__ __forceinline__ void operator()(const f32x4 (&acc)[2][2][4][2], const Unit& u, int wr, int wc, int fr, int fq) const {
        const int row0 = u.pm * BM + wr * 64 + fr, bidx = (u.pm * BM) / SEQL;
        const int col0 = u.pn * BM + wc * 32 + 8 * fq;
        const float* sw = shw + (size_t)bidx * NPROJ + col0;
        const int act = 0;
        f32x4 sv[2][2], gn[2][2];
#pragma unroll
        for (int bj = 0; bj < 2; ++bj)
#pragma unroll
            for (int n = 0; n < 2; ++n) { sv[bj][n] = *(const f32x4*)(sw + bj * HALF + 4 * n); gn[bj][n] = (act == 2) ? *(const f32x4*)(gnorm + (col0 - 1536) + bj * HALF + 4 * n) : (f32x4){1.f, 1.f, 1.f, 1.f}; }
#pragma unroll
        for (int ai = 0; ai < 2; ++ai)
#pragma unroll
            for (int m = 0; m < 4; ++m) {
                const int row = row0 + ai * HALF + m * 16;
                const float rs = __builtin_amdgcn_rsqf((float)rowss[row] * (1.0f / (4294967296.0f * DM)) + RMS_EPS_F);
#pragma unroll
                for (int bj = 0; bj < 2; ++bj) {
                    f32x4 v0 = acc[ai][bj][m][0] * rs + sv[bj][0], v1 = acc[ai][bj][m][1] * rs + sv[bj][1];
                    if (act == 1) {
#pragma unroll
                        for (int j = 0; j < 4; ++j) { v0[j] = gelu_tanh_f(v0[j]); v1[j] = gelu_tanh_f(v1[j]); }
                    } else if (act == 2) {
#pragma unroll
                        for (int j = 0; j < 4; ++j) { v0[j] = silu_f(v0[j]) * gn[bj][0][j]; v1[j] = silu_f(v1[j]) * gn[bj][1][j]; }
                    }
                    u32x4 w; w.x = cvt_pk_bf16(v0[0], v0[1]); w.y = cvt_pk_bf16(v0[2], v0[3]); w.z = cvt_pk_bf16(v1[0], v1[1]); w.w = cvt_pk_bf16(v1[2], v1[3]);
                    *(u32x4*)(O + (size_t)row * NPROJ + col0 + bj * HALF) = w;
                }
            }
    }
};

struct EpiResid {
    static constexpr bool PERM = true, AFTER_DRAIN = false;
    const float* basef; float* outf; bf16_t* hb; bf16_t* hs; const float* gate; const float* ngain; const float* nsc; unsigned long long* rowss_next; float gfac; int flags;
    template <bool BASE_F32> __device__ __forceinline__ void run(const f32x4 (&acc)[2][2][4][2], const Unit& u, int wr, int wc, int fr, int fq) const {
        const int row0 = u.pm * BM + wr * 64 + fr, bidx = (u.pm * BM) / SEQL;
        const int col0 = u.pn * BM + wc * 32 + 8 * fq;
        const bool out_f32 = !BASE_F32 && (flags & 2) != 0;
        f32x4 gv[2][2], nv[2][2];
#pragma unroll
        for (int bj = 0; bj < 2; ++bj)
#pragma unroll
            for (int n = 0; n < 2; ++n) {
                const int c = col0 + bj * HALF + 4 * n;
                gv[bj][n] = *(const f32x4*)(gate + (size_t)bidx * MODLD + c) * gfac;
                nv[bj][n] = *(const f32x4*)(ngain + c) * (*(const f32x4*)(nsc + (size_t)bidx * MODLD + c) + 1.0f);
            }
#pragma unroll
        for (int q4 = 0; q4 < 4; ++q4) {
            const int ai = q4 >> 1, m0 = 2 * (q4 & 1);
            f32x4 pre[2][2][2]; u32x4 raw[2][2];
#pragma unroll
            for (int mm = 0; mm < 2; ++mm) { const size_t off = (size_t)(row0 + ai * HALF + (m0 + mm) * 16) * DM + col0;
#pragma unroll
                for (int bj = 0; bj < 2; ++bj) {
                    if (BASE_F32) { pre[mm][bj][0] = *(const f32x4*)(basef + off + bj * HALF); pre[mm][bj][1] = *(const f32x4*)(basef + off + bj * HALF + 4); }
                    else raw[mm][bj] = *(const u32x4*)(hb + off + bj * HALF); } }
#pragma unroll
            for (int mm = 0; mm < 2; ++mm) {
                const int m = m0 + mm;
                const int row = row0 + ai * HALF + m * 16;
                const size_t off = (size_t)row * DM + col0;
                float ss = 0.f;
#pragma unroll
                for (int bj = 0; bj < 2; ++bj) {
                    f32x4 b0, b1;
                    if (BASE_F32) { b0 = pre[mm][bj][0]; b1 = pre[mm][bj][1]; }
                    else { const u32x4 r = raw[mm][bj];
                        b0 = (f32x4){__uint_as_float(r.x << 16), __uint_as_float(r.x & 0xffff0000u), __uint_as_float(r.y << 16), __uint_as_float(r.y & 0xffff0000u)};
                        b1 = (f32x4){__uint_as_float(r.z << 16), __uint_as_float(r.z & 0xffff0000u), __uint_as_float(r.w << 16), __uint_as_float(r.w & 0xffff0000u)}; }
                    const f32x4 o0 = b0 + gv[bj][0] * acc[ai][bj][m][0], o1 = b1 + gv[bj][1] * acc[ai][bj][m][1];
                    ss += (o0[0] * o0[0] + o0[1] * o0[1]) + (o0[2] * o0[2] + o0[3] * o0[3]) + (o1[0] * o1[0] + o1[1] * o1[1]) + (o1[2] * o1[2] + o1[3] * o1[3]);
                    u32x4 wb; wb.x = cvt_pk_bf16(o0[0], o0[1]); wb.y = cvt_pk_bf16(o0[2], o0[3]); wb.z = cvt_pk_bf16(o1[0], o1[1]); wb.w = cvt_pk_bf16(o1[2], o1[3]);
                    if (out_f32) { *(u32x4*)((bf16_t*)outf + off + bj * HALF) = wb; }
                    else {
                        *(u32x4*)(hb + off + bj * HALF) = wb;
                        const f32x4 s0 = o0 * nv[bj][0], s1 = o1 * nv[bj][1];
                        u32x4 w; w.x = cvt_pk_bf16(s0[0], s0[1]); w.y = cvt_pk_bf16(s0[2], s0[3]); w.z = cvt_pk_bf16(s1[0], s1[1]); w.w = cvt_pk_bf16(s1[2], s1[3]);
                        *(u32x4*)(hs + off + bj * HALF) = w;
                    }
                }
                ss += __shfl_xor(ss, 16); ss += __shfl_xor(ss, 32);
                if (fq == 0) atomicAdd(rowss_next + row, (unsigned long long)(ss * 4294967296.0f));
            }
        }
    }
    __device__ __forceinline__ void operator()(const f32x4 (&acc)[2][2][4][2], const Unit& u, int wr, int wc, int fr, int fq) const {
        if (flags & 1) run<true>(acc, u, wr, wc, fr, fq); else run<false>(acc, u, wr, wc, fr, fq);
    }
};

template <class T> __device__ __forceinline__ T* asg(unsigned long long v) {
    __attribute__((address_space(1))) T* g = (__attribute__((address_space(1))) T*)v; return (T*)g;
}
struct EpiAny {
    static constexpr bool PERM = true, AFTER_DRAIN = false;
    const PG8_LAS unsigned long long* et;
    __device__ __forceinline__ unsigned long long ld(int i) const {
        asm volatile("" ::: "memory");
        const unsigned long long v = et[i];
        const unsigned lo = __builtin_amdgcn_readfirstlane((unsigned)v), hi = __builtin_amdgcn_readfirstlane((unsigned)(v >> 32));
        return ((unsigned long long)hi << 32) | lo;
    }
    __device__ __forceinline__ void operator()(const f32x4 (&acc)[2][2][4][2], const Unit& u, int wr, int wc, int fr, int fq) const {
        const int mode = (int)ld(0);
        if (mode == 0) { EpiSwiglu e; e.O = asg<bf16_t>(ld(1)); e.rowss = asg<const unsigned long long>(ld(2)); e.shw = asg<const float>(ld(3)); e(acc, u, wr, wc, fr, fq); }
        else if (mode == 2) { EpiProj e; e.O = asg<bf16_t>(ld(1)); e.rowss = asg<const unsigned long long>(ld(2)); e.shw = asg<const float>(ld(3)); e.gnorm = asg<const float>(ld(4)); e(acc, u, wr, wc, fr, fq); }
        else if (mode == 9) { asm volatile("" :: "v"(acc[0][0][0][0]), "v"(acc[1][1][3][1]), "v"(acc[0][1][2][0]), "v"(acc[1][0][1][1])); }
        else { EpiResid e; e.basef = asg<const float>(ld(1)); e.outf = asg<float>(ld(2)); e.hs = asg<bf16_t>(ld(3)); e.gate = asg<const float>(ld(4)); e.ngain = asg<const float>(ld(5)); e.nsc = asg<const float>(ld(6));
               e.rowss_next = asg<unsigned long long>(ld(7)); e.gfac = __uint_as_float((unsigned)ld(8)); e.flags = (int)ld(9); e.hb = asg<bf16_t>(ld(10)); e(acc, u, wr, wc, fr, fq); }
    }
};
template <class Epi, class Sched, bool ALIGN_EPI = false, bool SP2 = false>
__device__ __forceinline__ void gemm_phase(PG8_LAS unsigned char* lds, const Gemm g, const Sched& S, const Epi& E) {
    int tid_o = threadIdx.x; asm volatile("" : "+v"(tid_o)); const int tid = tid_o, wid = __builtin_amdgcn_readfirstlane(tid >> 6), lane = tid & 63, wr = wid >> 2, wc = wid & 3, fr = lane & 15, fq = lane >> 4;
    const int K = g.K, nt = K / BK;
    unsigned voffA[2], voffB[2];
#pragma unroll
    for (int i = 0; i < 2; ++i) { int R, C; stage_rc(tid * 16 + i * 8192, R, C); const int Rb = Epi::PERM ? ((R & ~31) + perm32(R & 31)) : R;
        voffA[i] = (unsigned)(R * K + C) * 2u; voffB[i] = (unsigned)(Rb * K + C) * 2u; }
    const size_t kstep = (size_t)(BK * 2);
    const size_t hstep = (size_t)HALF * K * 2;
    const size_t tstep = 2 * hstep;
    const unsigned ldsw = (unsigned)wid * 1024u;
    const int aoff = lds_byte(wr * 64 + fr, fq * 8), boff = lds_byte(wc * 32 + fr, fq * 8);
#define PG8_SA(b, h) (((b) * 2 + (h)) * HTB)
#define PG8_SB(b, h) ((4 + (b) * 2 + (h)) * HTB)
#define PG8_STAGE(bufoff, gbase, voff) do { _Pragma("unroll") for (int _i = 0; _i < 2; ++_i) \
        __builtin_amdgcn_global_load_lds((const unsigned*)((const char*)(gbase) + (voff)[_i]), (PG8_LAS unsigned*)(lds + (bufoff) + ldsw + _i * 8192), 16, 0, 0); } while (0)
#define PG8_LDA(dst, b, h) do { _Pragma("unroll") for (int m = 0; m < 4; ++m) _Pragma("unroll") for (int k = 0; k < 2; ++k) dst[m][k] = *(const PG8_LAS bf16x8*)(lds + PG8_SA(b, h) + aoff + m * 2048 + k * 1024); } while (0)
#define PG8_LDB(dst, b, h) do { _Pragma("unroll") for (int n = 0; n < 2; ++n) _Pragma("unroll") for (int k = 0; k < 2; ++k) dst[n][k] = *(const PG8_LAS bf16x8*)(lds + PG8_SB(b, h) + boff + n * 2048 + k * 1024); } while (0)
#define PG8_MMA(ai, bj, At, Bt) do { __builtin_amdgcn_s_setprio(1); _Pragma("unroll") for (int m = 0; m < 4; ++m) _Pragma("unroll") for (int n = 0; n < 2; ++n) _Pragma("unroll") for (int k = 0; k < 2; ++k) \
        acc[ai][bj][m][n] = __builtin_amdgcn_mfma_f32_16x16x32_bf16(Bt[n][k], At[m][k], acc[ai][bj][m][n], 0, 0, 0); __builtin_amdgcn_s_setprio(0); } while (0)
#define PG8_WAIT_V(n) asm volatile("s_waitcnt vmcnt(" #n ")" ::: "memory")
#define PG8_WAIT_L(n) asm volatile("s_waitcnt lgkmcnt(" #n ")" ::: "memory")
#define PG8_BAR __builtin_amdgcn_s_barrier()
#define PG8_SCHED __builtin_amdgcn_sched_barrier(0)
    Unit cur, nxt; int ui = 0;
    if (!S.next(0, cur)) return;
    f32x4 acc[2][2][4][2];
#pragma unroll
    for (int a = 0; a < 2; ++a)
#pragma unroll
        for (int b = 0; b < 2; ++b)
#pragma unroll
            for (int m = 0; m < 4; ++m)
#pragma unroll
                for (int n = 0; n < 2; ++n) acc[a][b][m][n] = (f32x4){0.f, 0.f, 0.f, 0.f};
    bf16x8 At[4][2], B0[2][2], B1[2][2];
    const char* cA = (const char*)g.A + (size_t)cur.pm * tstep; const char* cB = (const char*)g.Bt + (size_t)cur.pn * tstep;
    S.a_ready(cur);
    if constexpr (SP2) {
        PG8_STAGE(PG8_SB(0, 0), cB, voffB); PG8_STAGE(PG8_SB(0, 1), cB + hstep, voffB); PG8_STAGE(PG8_SA(0, 0), cA, voffA); PG8_STAGE(PG8_SA(0, 1), cA + hstep, voffA);
        if (wr == 1) PG8_BAR;
        PG8_WAIT_V(2); PG8_BAR;
        PG8_STAGE(PG8_SB(1, 0), cB + kstep, voffB); PG8_STAGE(PG8_SA(1, 0), cA + kstep, voffA); PG8_STAGE(PG8_SB(1, 1), cB + hstep + kstep, voffB);
        PG8_WAIT_V(6); PG8_BAR;
    } else {
        PG8_STAGE(PG8_SB(0, 0), cB, voffB); PG8_STAGE(PG8_SA(0, 0), cA, voffA); PG8_STAGE(PG8_SB(0, 1), cB + hstep, voffB); PG8_STAGE(PG8_SA(0, 1), cA + hstep, voffA);
        if (wr == 1) PG8_BAR;
        PG8_WAIT_V(4); PG8_BAR;
        PG8_STAGE(PG8_SB(1, 0), cB + kstep, voffB); PG8_STAGE(PG8_SA(1, 0), cA + kstep, voffA); PG8_STAGE(PG8_SB(1, 1), cB + hstep + kstep, voffB);
        PG8_WAIT_V(6); PG8_BAR;
    }
    for (;;) {
        const bool has_next = S.next(ui + 1, nxt);
        const char* nA = has_next ? (const char*)g.A + (size_t)nxt.pm * tstep : cA; const char* nB = has_next ? (const char*)g.Bt + (size_t)nxt.pn * tstep : cB;
        for (int t = 0; t < nt; t += 2) {
            const bool last = (t == nt - 2);
            const char* a1 = cA + (size_t)(t + 1) * kstep;
            const char* a2 = last ? nA : cA + (size_t)(t + 2) * kstep; const char* b2 = last ? nB : cB + (size_t)(t + 2) * kstep;
            const char* a3 = a2 + kstep; const char* b3 = b2 + kstep;
            if (last && has_next) S.a_ready(nxt);
            if constexpr (SP2) {
            PG8_LDB(B0, 0, 0); PG8_LDB(B1, 0, 1); PG8_SCHED; PG8_LDA(At, 0, 0); PG8_STAGE(PG8_SA(1, 1), a1 + hstep, voffA);
            PG8_WAIT_V(8); PG8_WAIT_L(0); PG8_BAR; PG8_MMA(0, 0, At, B0); PG8_MMA(0, 1, At, B1); PG8_BAR; PG8_SCHED;
            PG8_LDA(At, 0, 1); PG8_STAGE(PG8_SB(0, 0), b2, voffB); PG8_STAGE(PG8_SB(0, 1), b2 + hstep, voffB); PG8_STAGE(PG8_SA(0, 0), a2, voffA);
            PG8_WAIT_V(8); PG8_WAIT_L(0); PG8_BAR; PG8_MMA(1, 0, At, B0); PG8_MMA(1, 1, At, B1); PG8_BAR; PG8_SCHED;
            PG8_LDB(B0, 1, 0); PG8_LDB(B1, 1, 1); PG8_SCHED; PG8_LDA(At, 1, 0); PG8_STAGE(PG8_SA(0, 1), a2 + hstep, voffA);
            PG8_WAIT_V(8); PG8_WAIT_L(0); PG8_BAR; PG8_MMA(0, 0, At, B0); PG8_MMA(0, 1, At, B1); PG8_BAR; PG8_SCHED;
            PG8_LDA(At, 1, 1); PG8_STAGE(PG8_SB(1, 0), b3, voffB); PG8_STAGE(PG8_SB(1, 1), b3 + hstep, voffB); PG8_STAGE(PG8_SA(1, 0), a3, voffA);
            PG8_WAIT_V(8); PG8_WAIT_L(0); PG8_BAR; PG8_MMA(1, 0, At, B0); PG8_MMA(1, 1, At, B1); PG8_BAR; PG8_SCHED;
            } else {
            PG8_LDB(B0, 0, 0); PG8_SCHED; PG8_LDA(At, 0, 0); PG8_STAGE(PG8_SA(1, 1), a1 + hstep, voffA);
            PG8_WAIT_L(8); PG8_BAR; PG8_WAIT_L(0); PG8_MMA(0, 0, At, B0); PG8_BAR; PG8_SCHED;
            PG8_LDB(B1, 0, 1); PG8_STAGE(PG8_SB(0, 0), b2, voffB);
            PG8_BAR; PG8_WAIT_L(0); PG8_MMA(0, 1, At, B1); PG8_BAR;
            PG8_LDA(At, 0, 1); PG8_STAGE(PG8_SA(0, 0), a2, voffA);
            PG8_BAR; PG8_WAIT_L(0); PG8_MMA(1, 0, At, B0); PG8_BAR; PG8_SCHED;
            PG8_STAGE(PG8_SB(0, 1), b2 + hstep, voffB);
            PG8_WAIT_V(6); PG8_BAR; PG8_MMA(1, 1, At, B1); PG8_BAR;
            PG8_LDB(B0, 1, 0); PG8_SCHED; PG8_LDA(At, 1, 0); PG8_STAGE(PG8_SA(0, 1), a2 + hstep, voffA);
            PG8_WAIT_L(8); PG8_BAR; PG8_WAIT_L(0); PG8_MMA(0, 0, At, B0); PG8_BAR; PG8_SCHED;
            PG8_LDB(B1, 1, 1); PG8_STAGE(PG8_SB(1, 0), b3, voffB);
            PG8_BAR; PG8_WAIT_L(0); PG8_MMA(0, 1, At, B1); PG8_BAR;
            PG8_LDA(At, 1, 1); PG8_STAGE(PG8_SA(1, 0), a3, voffA);
            PG8_BAR; PG8_WAIT_L(0); PG8_MMA(1, 0, At, B0); PG8_BAR; PG8_SCHED;
            PG8_STAGE(PG8_SB(1, 1), b3 + hstep, voffB);
            PG8_WAIT_V(6); PG8_BAR; PG8_MMA(1, 1, At, B1); PG8_BAR;
            }
        }
        if constexpr (ALIGN_EPI) { if (wr == 0) PG8_BAR; }
        if constexpr (!Epi::AFTER_DRAIN) { E(acc, cur, wr, wc, fr, fq); S.done(cur); }
        if (!has_next) break;
#pragma unroll
        for (int a = 0; a < 2; ++a)
#pragma unroll
            for (int b = 0; b < 2; ++b)
#pragma unroll
                for (int m = 0; m < 4; ++m)
#pragma unroll
                    for (int n = 0; n < 2; ++n) acc[a][b][m][n] = (f32x4){0.f, 0.f, 0.f, 0.f};
        cur = nxt; cA = nA; cB = nB; ++ui;
        if constexpr (ALIGN_EPI) { if (wr == 1) PG8_BAR; }
    }
    PG8_WAIT_V(0);
    if constexpr (!ALIGN_EPI) { if (wr == 0) PG8_BAR; }
    PG8_BAR;
    if constexpr (Epi::AFTER_DRAIN) { E.fused(acc, cur, wr, wc, fr, fq, lds, wid, lane); S.done(cur); }
#undef PG8_SA
#undef PG8_SB
#undef PG8_STAGE
#undef PG8_LDA
#undef PG8_LDB
#undef PG8_MMA
#undef PG8_WAIT_V
#undef PG8_WAIT_L
#undef PG8_BAR
#undef PG8_SCHED
}
}

#include <hip/hip_cooperative_groups.h>
#include <cstdio>
namespace cg = cooperative_groups;
using pg8::bf16_t; using pg8::bf16x8; using pg8::f32x4; using pg8::u32x4; using pg8::u32x2; using pg8::cvt_pk_bf16;
#define LAS __attribute__((address_space(3)))
constexpr int NWAVES = 8, NTHREADS = 512;
#ifndef REP_UP
#define REP_UP 1
#endif
#ifndef REP_SYNC
#define REP_SYNC 1
#endif
#ifndef REP_M1
#define REP_M1 1
#endif
#ifndef REP_SCAN
#define REP_SCAN 1
#endif
#ifndef REP_GMLP
#define REP_GMLP 1
#endif
#ifndef REP_WIN
#define REP_WIN 1
#endif
#ifndef REP_TAB
#define REP_TAB 1
#endif
#ifndef REP_MOD
#define REP_MOD 1
#endif
#ifndef PROBE_MODE
#define PROBE_MODE 1
#endif
#ifndef REP_DOWN
#define REP_DOWN 1
#endif
#ifndef REP_WOUT
#define REP_WOUT 1
#endif
#ifndef REP_MIX
#define REP_MIX 1
#endif
#ifndef REP_PRO
#define REP_PRO 1
#endif
constexpr int BATCH = 16, SEQ = 2048, D = 1024, M = BATCH * SEQ, FF = 2816, NP = 3072, NMOD = 9216, DEPTH = 2;
constexpr int LDS_BYTES = 147456;
constexpr size_t MiB = 1u << 20;
constexpr size_t WS_MODI = 0;
constexpr size_t WS_BAR = 2560 * 1024;
constexpr size_t WS_ROWSS = 3 * MiB;
constexpr size_t WS_ZERO_BYTES = 5 * MiB;
constexpr size_t WS_MOD = 5 * MiB;
constexpr float MOD_FX = 1099511627776.0f, ROWSS_FX = 4294967296.0f;
constexpr size_t WS_SHW = 6 * MiB + 256 * 1024;
constexpr int SHW_L = 16 * (2 * FF + NP + 2 * FF), SHW_O1 = 16 * 2 * FF, SHW_O2 = SHW_O1 + 16 * NP;
constexpr size_t WS_WSP = 90 * MiB;
constexpr size_t WS_W = 8 * MiB;
constexpr size_t W_13 = (size_t)2 * FF * D, W_2 = (size_t)D * FF, W_IN = (size_t)NP * D, W_OUT = (size_t)D * D;
constexpr size_t WL_13A = 0, WL_2A = WL_13A + W_13, WL_IN = WL_2A + W_2, WL_OUT = WL_IN + W_IN, WL_13B = WL_OUT + W_OUT, WL_2B = WL_13B + W_13, WL_TOTAL = WL_2B + W_2;
constexpr size_t WS_HS = 96 * MiB;
constexpr size_t WS_HF32 = 96 * MiB;
constexpr size_t WS_MIX = 160 * MiB;
constexpr size_t WS_R = 224 * MiB;
constexpr size_t WS_END = 416 * MiB;
static_assert(WS_W + 2 * WL_TOTAL * 2 <= WS_HS, "weights fit");
constexpr size_t HG_UNITS = 2048;
constexpr size_t WS_HQI = 416 * MiB;
constexpr size_t WS_HKS = 448 * MiB;
constexpr size_t WS_HVT = 480 * MiB;
constexpr size_t WS_HDK = 91 * MiB;
constexpr size_t WS_LB = 90 * MiB + 512 * 1024;
constexpr size_t WS_END2 = 512 * MiB;


__device__ __forceinline__ float bflo(unsigned u) { return __uint_as_float(u << 16); }
__device__ __forceinline__ float bfhi(unsigned u) { return __uint_as_float(u & 0xffff0000u); }
__device__ __forceinline__ unsigned f2bf(float f) { unsigned u = __builtin_bit_cast(unsigned, f); return (u + 0x7fffu + ((u >> 16) & 1u)) >> 16; }
__device__ __forceinline__ unsigned pk2(float lo, float hi) { return f2bf(lo) | (f2bf(hi) << 16); }
__device__ __forceinline__ float wave_sum(float v) {
#pragma unroll
    for (int o = 1; o < 64; o <<= 1) v += __shfl_xor(v, o);
    return v;
}
#define LDS_WAIT() asm volatile("s_waitcnt lgkmcnt(0)" ::: "memory")

#define RLX_AGENT __ATOMIC_RELAXED, __HIP_MEMORY_SCOPE_AGENT
#define XB_TMO      128
#define XB_XCNT(j)  (256  + 64 * (j))
#define XB_XSUB(j)  (1280 + 64 * (j))
#define XB_XGEN(j)  (2304 + 64 * (j))
#define XB_TOP      3328
#define XB_TOPGEN   3392
#define XCD_BAR_WORDS 3456
#define XB_SPIN_CAP (1u << 18)

__device__ __forceinline__ unsigned xb_ld(unsigned* p)              { return __hip_atomic_load(p, __ATOMIC_RELAXED, __HIP_MEMORY_SCOPE_AGENT); }
__device__ __forceinline__ unsigned xb_add(unsigned* p, unsigned v) { return __hip_atomic_fetch_add(p, v, __ATOMIC_RELAXED, __HIP_MEMORY_SCOPE_AGENT); }
__device__ __forceinline__ unsigned xb_xcc_id() { return (unsigned)__builtin_amdgcn_s_getreg((3 << 11) | 20) & 0xFu; }
#define XB_SPIN(cond, bar) do { unsigned _sp = 0; while (cond) { __builtin_amdgcn_s_sleep(1); \
    if ((++_sp & 255u) == 0u) { if (xb_ld(&(bar)[XB_TMO])) break; if (_sp > XB_SPIN_CAP) { atomicAdd(&(bar)[XB_TMO], 1u); break; } } } } while (0)

struct XcdBarrier {
    unsigned* bar; unsigned x;
    volatile LAS unsigned* st;
};

__device__ __forceinline__ XcdBarrier xcd_barrier_post(unsigned* bar, volatile LAS unsigned* st) {
    XcdBarrier b; b.bar = bar; b.x = xb_xcc_id(); b.st = st;
    if (threadIdx.x == 0) (void)xb_add(&bar[XB_XCNT(b.x)], 1u);
    return b;
}
__device__ __forceinline__ void xcd_barrier_complete(unsigned* bar, unsigned x, unsigned& nloc, unsigned& nx) {
    const unsigned G = gridDim.x * gridDim.y * gridDim.z;
    unsigned sum, cnt, mine, sp = 0u;
    for (;;) {
        sum = 0u; cnt = 0u; mine = 0u;
#pragma unroll
        for (unsigned j = 0; j < 16; ++j) { const unsigned c = xb_ld(&bar[XB_XCNT(j)]); sum += c; cnt += (c > 0u) ? 1u : 0u; mine = (j == x) ? c : mine; }
        if (sum == G) break;
        __builtin_amdgcn_s_sleep(1);
        if ((++sp & 255u) == 0u) { if (xb_ld(&bar[XB_TMO])) break; if (sp > XB_SPIN_CAP) { atomicAdd(&bar[XB_TMO], 1u); break; } }
    }
    nloc = mine > 0u ? mine : 1u; nx = cnt > 0u ? cnt : 1u;
}

__device__ __forceinline__ void xcd_barrier(const XcdBarrier& b) {
    asm volatile("s_waitcnt vmcnt(0)" ::: "memory");
    __syncthreads();
    if (threadIdx.x == 0) {
        unsigned* bar = b.bar;
        __builtin_amdgcn_s_waitcnt(0);
        unsigned nloc = b.st[0], nx = b.st[1];
        if (nloc == 0u) { xcd_barrier_complete(bar, b.x, nloc, nx); b.st[0] = nloc; b.st[1] = nx; }
        const unsigned old = xb_add(&bar[XB_XSUB(b.x)], 1u);
        const unsigned gen = old / nloc;
        if (old + 1u == (gen + 1u) * nloc) {
            __builtin_amdgcn_fence(__ATOMIC_RELEASE, "agent");
            asm volatile("s_waitcnt vmcnt(0)" ::: "memory");
            const unsigned og = xb_add(&bar[XB_TOP], 1u);
            const unsigned tg = og / nx;
            if (og + 1u == (tg + 1u) * nx) xb_add(&bar[XB_TOPGEN], 1u);
            else XB_SPIN(xb_ld(&bar[XB_TOPGEN]) == tg, bar);
            __builtin_amdgcn_fence(__ATOMIC_ACQUIRE, "agent");
            xb_add(&bar[XB_XGEN(b.x)], 1u);
            asm volatile("s_waitcnt vmcnt(0)" ::: "memory");
        } else {
            XB_SPIN(xb_ld(&bar[XB_XGEN(b.x)]) == gen, bar);
            __builtin_amdgcn_fence(__ATOMIC_ACQUIRE, "agent");
            asm volatile("s_waitcnt vmcnt(0)" ::: "memory");
        }
    }
    __syncthreads();
}

struct Args { const float* in[18]; float* out; unsigned char* ws; int ph_lo, ph_hi; };
constexpr int TAB_OFF = 139264, ET_OFF = TAB_OFF + 256, ST_OFF = TAB_OFF + 512;
typedef const LAS unsigned long long* ArgTab;
__device__ __forceinline__ bool tid0() { int t = threadIdx.x; asm volatile("" : "+v"(t)); return t == 0; }
__device__ __forceinline__ unsigned long long ldp(ArgTab tab, int i) {
    asm volatile("" ::: "memory");
    const unsigned long long v = tab[i];
    const unsigned lo = __builtin_amdgcn_readfirstlane((unsigned)v), hi = __builtin_amdgcn_readfirstlane((unsigned)(v >> 32));
    return ((unsigned long long)hi << 32) | lo;
}
template <class T> __device__ __forceinline__ T* as_global(unsigned long long v) {
    __attribute__((address_space(1))) T* g = (__attribute__((address_space(1))) T*)v;
    return (T*)g;
}
#define ARG_IN(i) (as_global<const float>(ldp(tab, (i))))
#define ARG_OUT() (as_global<float>(ldp(tab, 18)))
#define ARG_WS() (as_global<unsigned char>(ldp(tab, 19)))

__device__ __forceinline__ void transpose_item(const float* W, int K, int N, bf16_t* WT, int k0, int n0, int dst_row0, LAS float* scr, int lane) {
    float tv[32];
#pragma unroll
    for (int i = 0; i < 32; ++i) tv[i] = W[(size_t)(k0 + 2 * i + (lane >> 5)) * N + n0 + (lane & 31)];
#pragma unroll
    for (int i = 0; i < 32; ++i) scr[(2 * i + (lane >> 5)) * 33 + (lane & 31)] = tv[i];
    LDS_WAIT(); asm volatile("" ::: "memory");
    const int c = lane & 7;
#pragma unroll
    for (int j = 0; j < 4; ++j) { const int n = (lane >> 3) + 8 * j; const LAS float* s = scr + (8 * c) * 33 + n;
        u32x4 o; o.x = pk2(s[0 * 33], s[1 * 33]); o.y = pk2(s[2 * 33], s[3 * 33]); o.z = pk2(s[4 * 33], s[5 * 33]); o.w = pk2(s[6 * 33], s[7 * 33]);
        *(u32x4*)(WT + (size_t)(dst_row0 + n) * K + k0 + 8 * c) = o; }
    LDS_WAIT(); asm volatile("" ::: "memory");
}

__device__ __forceinline__ void convert_weights(ArgTab tab, LAS unsigned char* lds, int l, int gw, int NGW) {
    int tid_o = threadIdx.x; asm volatile("" : "+v"(tid_o)); const int tid = tid_o, lane = tid & 63, wave = __builtin_amdgcn_readfirstlane(tid >> 6);
    unsigned char* ws = ARG_WS();
    LAS float* scr = (LAS float*)(lds + 65536 + wave * 8448);
    constexpr int I13 = (D / 64) * (2 * FF / 32), I2 = (FF / 64) * (D / 32), IIN = (D / 64) * (NP / 32), IOUT = (D / 64) * (D / 32);
    constexpr int IL = 2 * I13 + 2 * I2 + IIN + IOUT;
    bf16_t* wl = (bf16_t*)(ws + WS_W) + (size_t)l * WL_TOTAL;
    for (int it = gw; it < IL; it += NGW) {
        int r = it;
        const float* src; int K, N; bf16_t* dst; bool is13 = false;
        if (r < I13) { src = ARG_IN(5) + (size_t)l * D * 2 * FF; K = D; N = 2 * FF; dst = wl + WL_13A; is13 = true; }
        else if ((r -= I13) < I2) { src = ARG_IN(6) + (size_t)l * FF * D; K = FF; N = D; dst = wl + WL_2A; }
        else if ((r -= I2) < IIN) { src = ARG_IN(7) + (size_t)l * D * NP; K = D; N = NP; dst = wl + WL_IN; }
        else if ((r -= IIN) < IOUT) { src = ARG_IN(14) + (size_t)l * D * D; K = D; N = D; dst = wl + WL_OUT; }
        else if ((r -= IOUT) < I13) { src = ARG_IN(15) + (size_t)l * D * 2 * FF; K = D; N = 2 * FF; dst = wl + WL_13B; is13 = true; }
        else { r -= I13; src = ARG_IN(16) + (size_t)l * FF * D; K = FF; N = D; dst = wl + WL_2B; }
        const int nblk = N / 32, kb = r / nblk, nb = r % nblk, k0 = 64 * kb, n0 = 32 * nb;
        int drow = n0;
        if (is13) { const int bj = n0 / FF, rr = n0 - bj * FF; drow = 256 * (rr / 128) + 128 * bj + (rr % 128); }
        transpose_item(src, K, N, dst, k0, n0, drow, scr, lane);
    }
}

__device__ __forceinline__ void shift_tables(ArgTab tab, int l, int gw, int NGW) {
    int tid_o = threadIdx.x; asm volatile("" : "+v"(tid_o)); const int tid = tid_o, lane = tid & 63, fr = lane & 15, fq = lane >> 4;
    unsigned char* ws = ARG_WS();
    const float* mod = (const float*)(ws + WS_MOD);
    constexpr int T13 = 2 * FF / 16, TIN = NP / 16, TL = 2 * T13 + TIN;
    for (int task = gw; task < TL; task += NGW) {
        int r = task;
        const bf16_t* wl = (const bf16_t*)(ws + WS_W) + (size_t)l * WL_TOTAL;
        float* shl = (float*)(ws + WS_SHW) + (size_t)l * SHW_L;
        const bf16_t* Bt; int N, sidx; float* dst;
        if (r < T13) { Bt = wl + WL_13A; N = 2 * FF; sidx = 0; dst = shl; }
        else if ((r -= T13) < TIN) { Bt = wl + WL_IN; N = NP; sidx = 3; dst = shl + SHW_O1; }
        else { r -= TIN; Bt = wl + WL_13B; N = 2 * FF; sidx = 6; dst = shl + SHW_O2; }
        const int n0 = r * 16;
        const float* ap = mod + ((size_t)l * 16 + fr) * NMOD + sidx * D + 8 * fq;
        const bf16_t* bp = Bt + (size_t)(n0 + fr) * D + 8 * fq;
        f32x4 acc = (f32x4){0.f, 0.f, 0.f, 0.f};
#pragma unroll 4
        for (int ks = 0; ks < 32; ++ks) {
            const f32x4 a0 = *(const f32x4*)(ap + ks * 32), a1 = *(const f32x4*)(ap + ks * 32 + 4);
            u32x4 aw; aw.x = cvt_pk_bf16(a0[0], a0[1]); aw.y = cvt_pk_bf16(a0[2], a0[3]); aw.z = cvt_pk_bf16(a1[0], a1[1]); aw.w = cvt_pk_bf16(a1[2], a1[3]);
            const bf16x8 af = __builtin_bit_cast(bf16x8, aw);
            const bf16x8 bf = *(const bf16x8*)(bp + ks * 32);
            acc = __builtin_amdgcn_mfma_f32_16x16x32_bf16(af, bf, acc, 0, 0, 0);
        }
#pragma unroll
        for (int j = 0; j < 4; ++j) dst[(size_t)(4 * fq + j) * N + n0 + fr] = acc[j];
    }
}

__device__ __forceinline__ void phase_prologue(ArgTab tab, LAS unsigned char* lds) {
    int tid_o = threadIdx.x; asm volatile("" : "+v"(tid_o)); const int tid = tid_o, lane = tid & 63, wave = __builtin_amdgcn_readfirstlane(tid >> 6);
    int bid_o = blockIdx.x; asm volatile("" : "+s"(bid_o)); const int G = gridDim.x, bid = bid_o;
    unsigned char* ws = ARG_WS();
    {
        LAS float* cact = (LAS float*)lds;
        const float* c = ARG_IN(1);
        for (int i = tid; i < 16 * 1024; i += NTHREADS) { const int b = i >> 10, k = i & 1023; const float v = c[i]; cact[k * 16 + b] = v / (1.0f + __expf(-v)); }
        __syncthreads();
        float* mod = (float*)(ws + WS_MOD);
        const float* w_ada = ARG_IN(2); const float* b_ada = ARG_IN(3);
        const int fr = lane & 15, fq = lane >> 4;
        for (int task = bid * NWAVES + wave; task < 2 * (NMOD / 16); task += G * NWAVES) {
            const int l = task / (NMOD / 16), n0 = (task % (NMOD / 16)) * 16;
            const float* wp = w_ada + ((size_t)l * D + fq) * NMOD + n0 + fr;
            const LAS float* cp = cact + lane;
            f32x4 acc = (f32x4){0.f, 0.f, 0.f, 0.f};
#pragma unroll 32
            for (int st = 0; st < D / 4; ++st)
                acc = __builtin_amdgcn_mfma_f32_16x16x4f32(cp[64 * st], wp[(size_t)(4 * st) * NMOD], acc, 0, 0, 0);
            const float bias = b_ada[l * NMOD + n0 + fr];
#pragma unroll
            for (int r = 0; r < 4; ++r) mod[((size_t)l * 16 + 4 * fq + r) * NMOD + n0 + fr] = acc[r] + bias;
        }
    }
    {
        convert_weights(tab, lds, 0, bid * NWAVES + wave, G * NWAVES);
        const float* wsp = ARG_IN(11); bf16_t* wspb = (bf16_t*)(ws + WS_WSP);
        for (int i = (bid * NTHREADS + tid) * 2; i < DEPTH * 4 * 128 * 128; i += G * NTHREADS * 2) *(unsigned*)(wspb + i) = pk2(wsp[i], wsp[i + 1]);
    }
}

__device__ __forceinline__ void phase_modconv(ArgTab tab) {
    int tid_o = threadIdx.x; asm volatile("" : "+v"(tid_o)); int bid_o = blockIdx.x; asm volatile("" : "+s"(bid_o));
    unsigned char* ws = ARG_WS();
    const long long* modi = (const long long*)(ws + WS_MODI); float* mod = (float*)(ws + WS_MOD);
    for (int i = bid_o * NTHREADS + tid_o; i < 2 * 16 * NMOD; i += (int)gridDim.x * NTHREADS) mod[i] = (float)modi[i] * (1.0f / MOD_FX);
}

__device__ __forceinline__ void phase_tables(ArgTab tab) {
    int tid_o = threadIdx.x; asm volatile("" : "+v"(tid_o)); const int tid = tid_o, lane = tid & 63, wave = __builtin_amdgcn_readfirstlane(tid >> 6), fr = lane & 15, fq = lane >> 4;
    int bid_o = blockIdx.x; asm volatile("" : "+s"(bid_o)); const int G = gridDim.x, gw = bid_o * NWAVES + wave, NGW = G * NWAVES;
    unsigned char* ws = ARG_WS();
    const float* mod = (const float*)(ws + WS_MOD);
    shift_tables(tab, 0, gw, NGW);
    {
        const float* lbl = ARG_IN(8); float* lb = (float*)(ws + WS_LB);
        if (bid_o == 0) for (int i = tid; i < 1024; i += NTHREADS) lb[i] = (i < 512) ? 0.f : 1.0f / (1.0f + __expf(lbl[i - 512] - lbl[i]));
    }
    {
        const float* x = ARG_IN(0); const float* gain = ARG_IN(4); bf16_t* hs = (bf16_t*)(ws + WS_HS); unsigned long long* rowss = (unsigned long long*)(ws + WS_ROWSS);
        for (int m0 = gw; m0 < M; m0 += 4 * NGW) {
            f32x4 v[4][4];
#pragma unroll
            for (int r = 0; r < 4; ++r) { const f32x4* xr = (const f32x4*)(x + (size_t)(m0 + r * NGW) * D) + lane;
#pragma unroll
                for (int j = 0; j < 4; ++j) v[r][j] = xr[64 * j]; }
#pragma unroll
            for (int r = 0; r < 4; ++r) {
                const int m = m0 + r * NGW, b = m / SEQ;
                const f32x4* gr = (const f32x4*)gain + lane;
                const f32x4* sr = (const f32x4*)(mod + (size_t)b * NMOD + 1 * D) + lane;
                float s = 0.f;
#pragma unroll
                for (int j = 0; j < 4; ++j) s += (v[r][j][0] * v[r][j][0] + v[r][j][1] * v[r][j][1]) + (v[r][j][2] * v[r][j][2] + v[r][j][3] * v[r][j][3]);
                s = wave_sum(s);
                if (lane == 0) rowss[m] = (unsigned long long)(s * ROWSS_FX);
                u32x2* o8 = (u32x2*)(hs + (size_t)m * D) + lane;
#pragma unroll
                for (int j = 0; j < 4; ++j) { const f32x4 sc = v[r][j] * (gr[64 * j] * (sr[64 * j] + 1.0f)); u32x2 w; w.x = cvt_pk_bf16(sc[0], sc[1]); w.y = cvt_pk_bf16(sc[2], sc[3]); o8[64 * j] = w; }
            }
        }
    }
}

__device__ __forceinline__ void phase_final(ArgTab tab) {
    int tid_o = threadIdx.x; asm volatile("" : "+v"(tid_o)); const int tid = tid_o, lane = tid & 63, wave = __builtin_amdgcn_readfirstlane(tid >> 6);
    int bid_o = blockIdx.x; asm volatile("" : "+s"(bid_o)); const int gw = bid_o * NWAVES + wave, NGW = gridDim.x * NWAVES;
    unsigned char* ws = ARG_WS();
    const unsigned long long* rowss = (const unsigned long long*)(ws + WS_ROWSS) + (size_t)6 * M; const float* fg = ARG_IN(17); float* outp = ARG_OUT(); const bf16_t* hf = (const bf16_t*)(ws + WS_HF32);
    for (int m0 = gw; m0 < M; m0 += 4 * NGW) {
        u32x2 rr[4][4];
#pragma unroll
        for (int r = 0; r < 4; ++r) { const u32x2* xr = (const u32x2*)(hf + (size_t)(m0 + r * NGW) * D) + lane;
#pragma unroll
            for (int j = 0; j < 4; ++j) rr[r][j] = xr[64 * j]; }
#pragma unroll
        for (int r = 0; r < 4; ++r) {
            const int m = m0 + r * NGW;
            const float rs = __builtin_amdgcn_rsqf((float)rowss[m] * (1.0f / (ROWSS_FX * D)) + 1e-6f);
            f32x4* orow = (f32x4*)(outp + (size_t)m * D) + lane; const f32x4* gr = (const f32x4*)fg + lane;
#pragma unroll
            for (int j = 0; j < 4; ++j) { const u32x2 q = rr[r][j]; orow[64 * j] = (f32x4){bflo(q.x), bfhi(q.x), bflo(q.y), bfhi(q.y)} * rs * gr[64 * j]; }
        }
    }
}

template <int CTRL> __device__ __forceinline__ float dpp_mul_shr(float p) {
    const int o = __builtin_amdgcn_update_dpp(__float_as_int(1.0f), __float_as_int(p), CTRL, 0xf, 0xf, false);
    return p * __int_as_float(o);
}
__device__ __forceinline__ float dpp_mul_bcast15(float p) {
    const int o = __builtin_amdgcn_update_dpp(__float_as_int(1.0f), __float_as_int(p), 0x142, 0xa, 0xf, false);
    return p * __int_as_float(o);
}
__device__ __forceinline__ float rdlane(float v, int l) { return __int_as_float(__builtin_amdgcn_readlane(__float_as_int(v), l)); }

__device__ __forceinline__ void hgrn_prep(LAS unsigned char* lds, const bf16_t* proj, unsigned char* ws, int layer, float* oi_base, bool st = true, int pm = 0) {
    int tid_o = threadIdx.x; asm volatile("" : "+v"(tid_o)); const int tid = tid_o, lane = tid & 63, wid = __builtin_amdgcn_readfirstlane(tid >> 6), fr = lane & 15, fq = lane >> 4;
    int bid_o = blockIdx.x; asm volatile("" : "+s"(bid_o)); const int bid = bid_o, G = gridDim.x;
    constexpr int QS = 136, TS = 72;
    LAS bf16_t* Q1 = (LAS bf16_t*)(lds);
    LAS bf16_t* Qi = (LAS bf16_t*)(lds + 8704);
    LAS bf16_t* Kd = (LAS bf16_t*)(lds + 26112);
    LAS bf16_t* KsT = (LAS bf16_t*)(lds + 43520);
    LAS bf16_t* vT = (LAS bf16_t*)(lds + 61952);
    LAS bf16_t* Am = (LAS bf16_t*)(lds + 80384);
    const float* lbt = (const float*)(ws + WS_LB) + layer * 512;
    u32x4 rq[2], rf[2], rv[2];
    {
        const int u = bid; const int seq = u >> 5, c = u & 31, b = seq >> 2, hd = seq & 3;
        if (u < (int)HG_UNITS) {
            const bf16_t* pq = proj + ((size_t)b * SEQ + c * 64 + lane) * NP + hd * 128 + 16 * wid;
            rq[0] = *(const u32x4*)(pq); rq[1] = *(const u32x4*)(pq + 8); rf[0] = *(const u32x4*)(pq + 512); rf[1] = *(const u32x4*)(pq + 520); rv[0] = *(const u32x4*)(pq + 1024); rv[1] = *(const u32x4*)(pq + 1032);
        }
    }
    for (int u = bid; u < (int)HG_UNITS; u += G) {
        const int seq = u >> 5, hd = seq & 3;
        bf16_t* gqi = (bf16_t*)(ws + WS_HQI) + (size_t)u * 8192;
        bf16_t* gks = (bf16_t*)(ws + WS_HKS) + (size_t)u * 8192;
        bf16_t* gvt = (bf16_t*)(ws + WS_HVT) + (size_t)u * 8192;
        float* goi = oi_base + (size_t)u * 8192;
        float* gdk = (float*)(ws + WS_HDK) + (size_t)u * 128;
        {
            float q[16], P[16], kk[16];
#pragma unroll
            for (int h2 = 0; h2 < 2; ++h2)
#pragma unroll
                for (int j = 0; j < 4; ++j) {
                    const unsigned uq = rq[h2][j], uf = rf[h2][j];
                    q[8 * h2 + 2 * j] = bflo(uq); q[8 * h2 + 2 * j + 1] = bfhi(uq);
                    P[8 * h2 + 2 * j] = bflo(uf); P[8 * h2 + 2 * j + 1] = bfhi(uf);
                }
            const float* lbp = lbt + hd * 128 + 16 * wid;
#pragma unroll
            for (int j = 0; j < 16; ++j) {
                const float x = fminf(fmaxf(P[j], -30.f), 30.f);
                const float e = __expf(-x), sg = pg8::fast_rcp(1.0f + e);
                const float lbj = lbp[j], om = 1.0f - lbj;
                P[j] = lbj + om * sg;
                kk[j] = om * e * sg;
            }
#pragma unroll
            for (int j = 0; j < 16; ++j) { float p = P[j]; p = dpp_mul_shr<0x111>(p); p = dpp_mul_shr<0x112>(p); p = dpp_mul_shr<0x114>(p); p = dpp_mul_shr<0x118>(p); p = dpp_mul_bcast15(p); P[j] = p; }
            unsigned wqi[8], wq1[8], wkd[8];
            float ks[16], dka[16];
            const bool lo = lane < 32;
#pragma unroll
            for (int j = 0; j < 16; j += 2) {
                float qi[2], q1[2], kd[2];
#pragma unroll
                for (int e2 = 0; e2 < 2; ++e2) {
                    const float H = P[j + e2];
                    const float h0 = rdlane(H, 31), h1 = rdlane(H, 63), dkv = h0 * h1;
                    const float rH = pg8::fast_rcp(fmaxf(H, 1e-37f)), qH = q[j + e2] * H, kr = kk[j + e2] * rH;
                    qi[e2] = lo ? qH : qH * h0;
                    q1[e2] = qH;
                    kd[e2] = kr;
                    ks[j + e2] = kr * (lo ? dkv : h1);
                    dka[j + e2] = dkv;
                }
                wqi[j >> 1] = cvt_pk_bf16(qi[0], qi[1]); wq1[j >> 1] = cvt_pk_bf16(q1[0], q1[1]); wkd[j >> 1] = cvt_pk_bf16(kd[0], kd[1]);
            }
            if (lane == 0 && st) {
#pragma unroll
                for (int j4 = 0; j4 < 4; ++j4) *(f32x4*)(gdk + 16 * wid + 4 * j4) = (f32x4){dka[4 * j4], dka[4 * j4 + 1], dka[4 * j4 + 2], dka[4 * j4 + 3]};
            }
            const u32x4 qa = (u32x4){wqi[0], wqi[1], wqi[2], wqi[3]}, qb = (u32x4){wqi[4], wqi[5], wqi[6], wqi[7]};
            *(LAS u32x4*)(Qi + lane * QS + 16 * wid) = qa; *(LAS u32x4*)(Qi + lane * QS + 16 * wid + 8) = qb;
            if (st) { *(u32x4*)(gqi + lane * 128 + 16 * wid) = qa; *(u32x4*)(gqi + lane * 128 + 16 * wid + 8) = qb; }
            if (lane >= 32) {
                *(LAS u32x4*)(Q1 + (lane - 32) * QS + 16 * wid) = (u32x4){wq1[0], wq1[1], wq1[2], wq1[3]};
                *(LAS u32x4*)(Q1 + (lane - 32) * QS + 16 * wid + 8) = (u32x4){wq1[4], wq1[5], wq1[6], wq1[7]};
            }
            *(LAS u32x4*)(Kd + lane * QS + 16 * wid) = (u32x4){wkd[0], wkd[1], wkd[2], wkd[3]};
            *(LAS u32x4*)(Kd + lane * QS + 16 * wid + 8) = (u32x4){wkd[4], wkd[5], wkd[6], wkd[7]};
            {
                const unsigned psel = (lane & 1) ? 0x03020706u : 0x05040100u;
                const int rsel = lane & 1, s2 = lane & ~1;
#pragma unroll
                for (int i = 0; i < 8; ++i) {
                    const unsigned pk = cvt_pk_bf16(ks[2 * i], ks[2 * i + 1]);
                    const unsigned pr = (unsigned)__builtin_amdgcn_mov_dpp((int)pk, 0xB1, 0xf, 0xf, true);
                    *(LAS unsigned*)(KsT + (16 * wid + 2 * i + rsel) * TS + s2) = __builtin_amdgcn_perm(pr, pk, psel);
                }
#pragma unroll
                for (int h2 = 0; h2 < 2; ++h2)
#pragma unroll
                    for (int j = 0; j < 4; ++j) {
                        const unsigned pk = rv[h2][j];
                        const unsigned pr = (unsigned)__builtin_amdgcn_mov_dpp((int)pk, 0xB1, 0xf, 0xf, true);
                        *(LAS unsigned*)(vT + (16 * wid + 8 * h2 + 2 * j + rsel) * TS + s2) = __builtin_amdgcn_perm(pr, pk, psel);
                    }
            }
        }
        {
            const int un = u + G;
            if (un < (int)HG_UNITS && pm != 4) {
                const int seqn = un >> 5, cn = un & 31, bn = seqn >> 2, hdn = seqn & 3;
                const bf16_t* pq = proj + ((size_t)bn * SEQ + cn * 64 + lane) * NP + hdn * 128 + 16 * wid;
                rq[0] = *(const u32x4*)(pq); rq[1] = *(const u32x4*)(pq + 8); rf[0] = *(const u32x4*)(pq + 512); rf[1] = *(const u32x4*)(pq + 520); rv[0] = *(const u32x4*)(pq + 1024); rv[1] = *(const u32x4*)(pq + 1032);
            }
        }
        __syncthreads();
        if (pm != 2) {
            const int ti = wid >> 1, tb = ti >> 1;
#pragma unroll
            for (int i = 0; i < 2; ++i) {
                const int sj = 2 * (wid & 1) + i, sb = sj >> 1;
                f32x4 sa = (f32x4){0.f, 0.f, 0.f, 0.f};
                if (tb >= sb) {
                    const LAS bf16_t* qa = (sb == 0) ? (Qi + (16 * ti + fr) * QS + 8 * fq) : (Q1 + (16 * ti - 32 + fr) * QS + 8 * fq);
                    const LAS bf16_t* kb = Kd + (16 * sj + fr) * QS + 8 * fq;
#pragma unroll
                    for (int ks2 = 0; ks2 < 4; ++ks2)
                        sa = __builtin_amdgcn_mfma_f32_16x16x32_bf16(*(const LAS bf16x8*)(qa + 32 * ks2), *(const LAS bf16x8*)(kb + 32 * ks2), sa, 0, 0, 0);
                }
                const int s = 16 * sj + fr;
#pragma unroll
                for (int r = 0; r < 4; ++r) { const int t = 16 * ti + 4 * fq + r; Am[t * TS + s] = (bf16_t)f2bf((s <= t) ? sa[r] : 0.f); }
            }
#pragma unroll
            for (int i = 0; i < 2; ++i) {
                const int ch = tid + 512 * i, row = ch >> 3, c8 = ch & 7;
                if (st) { *(u32x4*)(gks + row * 64 + 8 * c8) = *(const LAS u32x4*)(KsT + row * TS + 8 * c8);
                *(u32x4*)(gvt + row * 64 + 8 * c8) = *(const LAS u32x4*)(vT + row * TS + 8 * c8); }
            }
        }
        __syncthreads();
        if (pm != 2) {
            f32x4 o[4];
#pragma unroll
            for (int ti = 0; ti < 4; ++ti) o[ti] = (f32x4){0.f, 0.f, 0.f, 0.f};
#pragma unroll
            for (int ks2 = 0; ks2 < 2; ++ks2) {
                const bf16x8 bv = *(const LAS bf16x8*)(vT + (16 * wid + fr) * TS + 32 * ks2 + 8 * fq);
#pragma unroll
                for (int ti = 0; ti < 4; ++ti)
                    o[ti] = __builtin_amdgcn_mfma_f32_16x16x32_bf16(*(const LAS bf16x8*)(Am + (16 * ti + fr) * TS + 32 * ks2 + 8 * fq), bv, o[ti], 0, 0, 0);
            }
#pragma unroll
            for (int ti = 0; ti < 4; ++ti) { if (st) *(f32x4*)(goi + ((wid * 4 + ti) * 64 + lane) * 4) = o[ti]; else asm volatile("" :: "v"(o[ti])); }
        }
        __syncthreads();
    }
}

struct HgStage { u32x4 qi[2], ks[2], g[2]; bf16x8 vt[2]; f32x4 oi[4]; float dk; };
__device__ __forceinline__ void hgrn_scan(LAS unsigned char* lds, const bf16_t* proj, bf16_t* mix, unsigned char* ws, const float* gnorm, const float* oi_base, int seq, int pm = 0) {
    int tid_o = threadIdx.x; asm volatile("" : "+v"(tid_o)); const int tid = tid_o, lane = tid & 63, wid = __builtin_amdgcn_readfirstlane(tid >> 6), fr = lane & 15, fq = lane >> 4;
    const int b = seq >> 2, hd = seq & 3;
    constexpr int QS = 136, TS = 72, OS = 132;
    LAS bf16_t* Qi = (LAS bf16_t*)(lds);
    LAS bf16_t* KsT = (LAS bf16_t*)(lds + 17408);
    LAS bf16_t* ST = (LAS bf16_t*)(lds + 35840);
    LAS float*  Of = (LAS float*)(lds + 70656);
    LAS float*  dk = (LAS float*)(lds + 104448);
    for (int i = tid; i < 128 * QS / 2; i += NTHREADS) ((LAS unsigned*)ST)[i] = 0u;
    const int tq = tid >> 3, part = tid & 7;
    LAS float*  gns = (LAS float*)(lds + 105472);
    if (tid < 128) gns[tid] = gnorm[hd * 128 + tid];
    f32x4 S[8];
#pragma unroll
    for (int kt = 0; kt < 8; ++kt) S[kt] = (f32x4){0.f, 0.f, 0.f, 0.f};
    const size_t u0 = (size_t)seq * 32;
    const bf16_t* gqi = (const bf16_t*)(ws + WS_HQI) + u0 * 8192;
    const bf16_t* gks = (const bf16_t*)(ws + WS_HKS) + u0 * 8192;
    const bf16_t* gvt = (const bf16_t*)(ws + WS_HVT) + u0 * 8192;
    const float* goi = oi_base + u0 * 8192;
    const float* gdk = (const float*)(ws + WS_HDK) + u0 * 128;
    const bf16_t* pg = proj + ((size_t)b * SEQ + tq) * NP + 1536 + hd * 128 + 16 * part;
    const int ch0 = tid, ch1 = tid + 512;
    HgStage sA, sB; sA.dk = 0.f; sB.dk = 0.f;
#define HG_LOAD(st, c) do { const size_t uo = (size_t)(c); \
        st.qi[0] = *(const u32x4*)(gqi + uo * 8192 + ch0 * 8); st.qi[1] = *(const u32x4*)(gqi + uo * 8192 + ch1 * 8); \
        st.ks[0] = *(const u32x4*)(gks + uo * 8192 + ch0 * 8); st.ks[1] = *(const u32x4*)(gks + uo * 8192 + ch1 * 8); \
        st.vt[0] = *(const bf16x8*)(gvt + uo * 8192 + (16 * wid + fr) * 64 + 8 * fq); st.vt[1] = *(const bf16x8*)(gvt + uo * 8192 + (16 * wid + fr) * 64 + 32 + 8 * fq); \
        _Pragma("unroll") for (int ti = 0; ti < 4; ++ti) st.oi[ti] = *(const f32x4*)(goi + uo * 8192 + ((wid * 4 + ti) * 64 + lane) * 4); \
        if (tid < 128) st.dk = gdk[uo * 128 + tid]; \
        st.g[0] = *(const u32x4*)(pg + uo * 64 * NP); st.g[1] = *(const u32x4*)(pg + uo * 64 * NP + 8); } while (0)
#define HG_STEP(st, c) do { \
          \
        *(LAS u32x4*)(Qi + (ch0 >> 4) * QS + 8 * (ch0 & 15)) = st.qi[0]; *(LAS u32x4*)(Qi + (ch1 >> 4) * QS + 8 * (ch1 & 15)) = st.qi[1]; \
        *(LAS u32x4*)(KsT + (ch0 >> 3) * TS + 8 * (ch0 & 7)) = st.ks[0]; *(LAS u32x4*)(KsT + (ch1 >> 3) * TS + 8 * (ch1 & 7)) = st.ks[1]; \
        if (tid < 128) dk[((c) & 1) * 128 + tid] = st.dk; \
        f32x4 o[4]; bf16x8 bv[2]; u32x4 g[2]; \
        _Pragma("unroll") for (int ti = 0; ti < 4; ++ti) o[ti] = st.oi[ti]; \
        bv[0] = st.vt[0]; bv[1] = st.vt[1]; g[0] = st.g[0]; g[1] = st.g[1]; \
        if ((c) + 2 < 32 && pm != 2) HG_LOAD(st, (c) + 2); \
        __syncthreads(); \
          \
        if (pm != 3) { _Pragma("unroll") for (int ks2 = 0; ks2 < 4; ++ks2) { \
            const bf16x8 bs = *(const LAS bf16x8*)(ST + (16 * wid + fr) * QS + 32 * ks2 + 8 * fq); \
            _Pragma("unroll") for (int ti = 0; ti < 4; ++ti) \
                o[ti] = __builtin_amdgcn_mfma_f32_16x16x32_bf16(*(const LAS bf16x8*)(Qi + (16 * ti + fr) * QS + 32 * ks2 + 8 * fq), bs, o[ti], 0, 0, 0); \
        } \
        _Pragma("unroll") for (int kt = 0; kt < 8; ++kt) { const f32x4 dv = *(const LAS f32x4*)(dk + ((c) & 1) * 128 + 16 * kt + 4 * fq); S[kt] = S[kt] * dv; } \
        _Pragma("unroll") for (int ks2 = 0; ks2 < 2; ++ks2) \
            _Pragma("unroll") for (int kt = 0; kt < 8; ++kt) \
                S[kt] = __builtin_amdgcn_mfma_f32_16x16x32_bf16(*(const LAS bf16x8*)(KsT + (16 * kt + fr) * TS + 32 * ks2 + 8 * fq), bv[ks2], S[kt], 0, 0, 0); } \
        __syncthreads(); \
          \
        _Pragma("unroll") for (int ti = 0; ti < 4; ++ti) \
            _Pragma("unroll") for (int r = 0; r < 4; ++r) Of[(16 * ti + 4 * fq + r) * OS + 16 * wid + fr] = o[ti][r]; \
        _Pragma("unroll") for (int kt = 0; kt < 8; ++kt) { \
            u32x2 w2; w2.x = cvt_pk_bf16(S[kt][0], S[kt][1]); w2.y = cvt_pk_bf16(S[kt][2], S[kt][3]); \
            *(LAS u32x2*)(ST + (16 * wid + fr) * QS + 16 * kt + 4 * fq) = w2; \
        } \
        __syncthreads(); \
          \
        { \
            float ov[16]; float ss = 0.f; \
            _Pragma("unroll") for (int j4 = 0; j4 < 4; ++j4) { const f32x4 t4 = *(const LAS f32x4*)(Of + tq * OS + 16 * part + 4 * j4); ov[4 * j4] = t4[0]; ov[4 * j4 + 1] = t4[1]; ov[4 * j4 + 2] = t4[2]; ov[4 * j4 + 3] = t4[3]; \
                ss += (t4[0] * t4[0] + t4[1] * t4[1]) + (t4[2] * t4[2] + t4[3] * t4[3]); } \
            ss += __shfl_xor(ss, 1); ss += __shfl_xor(ss, 2); ss += __shfl_xor(ss, 4); \
            const float rs = __builtin_amdgcn_rsqf(ss * (1.0f / 128.0f) + 1e-6f); \
            unsigned w[8]; \
            _Pragma("unroll") for (int h2 = 0; h2 < 2; ++h2) \
                _Pragma("unroll") for (int j = 0; j < 4; ++j) { \
                    const unsigned ug = g[h2][j]; const float g0 = bflo(ug), g1 = bfhi(ug); const int e = 8 * h2 + 2 * j; \
                    w[4 * h2 + j] = cvt_pk_bf16(ov[e] * (rs * gns[16 * part + e] * pg8::silu_f(g0)), ov[e + 1] * (rs * gns[16 * part + e + 1] * pg8::silu_f(g1))); \
                } \
            bf16_t* po = mix + ((size_t)b * SEQ + (size_t)(c) * 64 + tq) * D + hd * 128 + 16 * part; \
            if (pm == 0) { *(u32x4*)(po) = (u32x4){w[0], w[1], w[2], w[3]}; *(u32x4*)(po + 8) = (u32x4){w[4], w[5], w[6], w[7]}; } else asm volatile("" :: "v"(w[0]), "v"(w[1]), "v"(w[2]), "v"(w[3]), "v"(w[4]), "v"(w[5]), "v"(w[6]), "v"(w[7])); \
        } \
          \
    } while (0)
    HG_LOAD(sA, 0); HG_LOAD(sB, 1);
    __syncthreads();
    for (int c = 0; c < 32; c += 2) { HG_STEP(sA, c); HG_STEP(sB, c + 1); }
#undef HG_LOAD
#undef HG_STEP
    __syncthreads();
}

__device__ __forceinline__ void gmlp_units(LAS unsigned char* lds, const bf16_t* proj, bf16_t* mix, const bf16_t* wspb, const float* lng, const float* bsp, const float* og, int u_first, int u_stride) {
    int tid_o = threadIdx.x; asm volatile("" : "+v"(tid_o)); const int tid = tid_o, lane = tid & 63, wid = __builtin_amdgcn_readfirstlane(tid >> 6), fr = lane & 15, fq = lane >> 4;
    constexpr int VS = 136;
    LAS bf16_t* vnT = (LAS bf16_t*)(lds);
    LAS bf16_t* Ug = (LAS bf16_t*)(lds + 34816);
    const int s = tid >> 2, p4 = tid & 3;
    u32x4 ru[4], rv[4];
    if (u_first < 1024) {
        const int hd = u_first & 3, nb = (u_first >> 2) & 15, b = u_first >> 6;
        const bf16_t* pu = proj + ((size_t)b * SEQ + nb * 128 + s) * NP + 2048 + hd * 128 + 32 * p4;
#pragma unroll
        for (int j = 0; j < 4; ++j) { ru[j] = *(const u32x4*)(pu + 8 * j); rv[j] = *(const u32x4*)(pu + 512 + 8 * j); }
    }
    for (int unit = u_first; unit < 1024; unit += u_stride) {
        const int hd = unit & 3, nb = (unit >> 2) & 15, b = unit >> 6;
        const size_t row0 = (size_t)b * SEQ + nb * 128;
        bf16x8 af[4];
        {
            const bf16_t* wa = wspb + ((size_t)hd * 128 + 16 * wid + fr) * 128 + 8 * fq;
#pragma unroll
            for (int ks = 0; ks < 4; ++ks) af[ks] = *(const bf16x8*)(wa + 32 * ks);
        }
        {
#pragma unroll
            for (int j = 0; j < 4; ++j) { u32x4 gu;
#pragma unroll
                for (int e = 0; e < 4; ++e) gu[e] = cvt_pk_bf16(pg8::gelu_tanh_f(bflo(ru[j][e])), pg8::gelu_tanh_f(bfhi(ru[j][e])));
                *(LAS u32x4*)(Ug + s * VS + 32 * p4 + 8 * j) = gu; }
            float v[32]; float sum = 0.f;
#pragma unroll
            for (int j = 0; j < 4; ++j)
#pragma unroll
                for (int e = 0; e < 4; ++e) { v[8 * j + 2 * e] = pg8::gelu_tanh_f(bflo(rv[j][e])); v[8 * j + 2 * e + 1] = pg8::gelu_tanh_f(bfhi(rv[j][e])); sum += v[8 * j + 2 * e] + v[8 * j + 2 * e + 1]; }
            {
                const int un = unit + u_stride;
                if (un < 1024) {
                    const int hdn = un & 3, nbn = (un >> 2) & 15, bn = un >> 6;
                    const bf16_t* pu = proj + ((size_t)bn * SEQ + nbn * 128 + s) * NP + 2048 + hdn * 128 + 32 * p4;
#pragma unroll
                    for (int j = 0; j < 4; ++j) { ru[j] = *(const u32x4*)(pu + 8 * j); rv[j] = *(const u32x4*)(pu + 512 + 8 * j); }
                }
            }
            sum += __shfl_xor(sum, 1); sum += __shfl_xor(sum, 2);
            const float mu = sum * (1.0f / 128.0f); float sq = 0.f;
#pragma unroll
            for (int j = 0; j < 32; ++j) { v[j] -= mu; sq += v[j] * v[j]; }
            sq += __shfl_xor(sq, 1); sq += __shfl_xor(sq, 2);
            const float rstd = __builtin_amdgcn_rsqf(sq * (1.0f / 128.0f) + 1e-5f);
            const float* lg = lng + hd * 128 + 32 * p4;
#pragma unroll
            for (int j = 0; j < 32; ++j) vnT[(32 * p4 + j) * VS + s] = (bf16_t)f2bf(v[j] * rstd * lg[j]);
        }
        __syncthreads();
        {
            f32x4 acc[8];
#pragma unroll
            for (int dt = 0; dt < 8; ++dt) acc[dt] = (f32x4){0.f, 0.f, 0.f, 0.f};
#pragma unroll
            for (int ks = 0; ks < 4; ++ks) {
                if (ks < 2 || wid >= 4) {
#pragma unroll
                    for (int dt = 0; dt < 8; ++dt)
                        acc[dt] = __builtin_amdgcn_mfma_f32_16x16x32_bf16(af[ks], *(const LAS bf16x8*)(vnT + (16 * dt + fr) * VS + 32 * ks + 8 * fq), acc[dt], 0, 0, 0);
                }
            }
            float bs[4], ss[4];
#pragma unroll
            for (int r = 0; r < 4; ++r) { bs[r] = bsp[hd * 128 + 16 * wid + 4 * fq + r]; ss[r] = 0.f; }
#pragma unroll
            for (int dt = 0; dt < 8; ++dt)
#pragma unroll
                for (int r = 0; r < 4; ++r) {
                    const float uval = __uint_as_float((unsigned)Ug[(16 * wid + 4 * fq + r) * VS + 16 * dt + fr] << 16);
                    const float y = uval * (acc[dt][r] + bs[r]); acc[dt][r] = y; ss[r] += y * y;
                }
#pragma unroll
            for (int r = 0; r < 4; ++r) { float s2 = ss[r]; s2 += __shfl_xor(s2, 1); s2 += __shfl_xor(s2, 2); s2 += __shfl_xor(s2, 4); s2 += __shfl_xor(s2, 8); ss[r] = __builtin_amdgcn_rsqf(s2 * (1.0f / 128.0f) + 1e-6f); }
#pragma unroll
            for (int dt = 0; dt < 8; ++dt) { const float gq = og[hd * 128 + 16 * dt + fr];
#pragma unroll
                for (int r = 0; r < 4; ++r) Ug[(16 * wid + 4 * fq + r) * VS + 16 * dt + fr] = (bf16_t)f2bf(acc[dt][r] * ss[r] * gq); }
        }
        __syncthreads();
        {
            bf16_t* po = mix + (row0 + s) * D + 512 + hd * 128 + 32 * p4;
#pragma unroll
            for (int j = 0; j < 4; ++j) *(u32x4*)(po + 8 * j) = *(const LAS u32x4*)(Ug + s * VS + 32 * p4 + 8 * j);
        }
        __syncthreads();
    }
}

constexpr int N_PHASES = 19;
__global__ void __launch_bounds__(NTHREADS, 2) fwd_megakernel(Args args) {
    extern __shared__ __attribute__((aligned(16))) unsigned char lds_raw[];
    LAS unsigned char* lds = (LAS unsigned char*)lds_raw;
    cg::grid_group grid = cg::this_grid();
    {
        const __attribute__((address_space(4))) unsigned long long* ka = (const __attribute__((address_space(4))) unsigned long long*)__builtin_amdgcn_kernarg_segment_ptr();
        if (threadIdx.x < 20) ((LAS unsigned long long*)(lds + TAB_OFF))[threadIdx.x] = ka[threadIdx.x];
        if (threadIdx.x < 4) ((LAS unsigned*)(lds + ST_OFF))[threadIdx.x] = 0u;
        __syncthreads();
    }
    ArgTab tab = (ArgTab)(lds + TAB_OFF);
    const XcdBarrier xbar = xcd_barrier_post((unsigned*)(args.ws + WS_BAR), (volatile LAS unsigned*)(lds + ST_OFF));
    const int G = gridDim.x;
    for (int ph = args.ph_lo; ph < args.ph_hi; ++ph) {
#ifndef DIS_PRO
        if (ph == 0) phase_prologue(tab, lds);
        else
#endif
#ifndef DIS_TAB
        if (ph == 1) for (int rep_ = 0; rep_ < REP_TAB; ++rep_) phase_tables(tab);
        else
#endif
        if (ph < 2) {}
        else if (ph == N_PHASES - 1) phase_final(tab);
        else {
            const int l = (ph - 2) / 8, p8 = (ph - 2) % 8, s = (p8 <= 3) ? p8 : (p8 == 4 ? 7 : p8 - 1);
            unsigned char* ws = ARG_WS();
            float* mod = (float*)(ws + WS_MOD);
            unsigned long long* rowss = (unsigned long long*)(ws + WS_ROWSS);
            bf16_t* hs = (bf16_t*)(ws + WS_HS);
            bf16_t* mix = (bf16_t*)(ws + WS_MIX);
            bf16_t* R = (bf16_t*)(ws + WS_R);
            const bf16_t* wl = (const bf16_t*)(ws + WS_W) + (size_t)l * WL_TOTAL;
            const float* shl = (const float*)(ws + WS_SHW) + (size_t)l * SHW_L;
            const float* modl = mod + (size_t)l * 16 * NMOD;
#ifndef DIS_GEMM
            if (s != 3 && s != 7) {
                LAS unsigned long long* et = (LAS unsigned long long*)(lds + ET_OFF);
                const bf16_t* A; const bf16_t* Bt; int N, K;
                if (s == 0 || s == 5) {
                    A = hs; Bt = wl + (s == 0 ? WL_13A : WL_13B); N = 2 * FF; K = D;
                    if (tid0()) { et[0] = 0ull; et[1] = (unsigned long long)R; et[2] = (unsigned long long)(rowss + (size_t)(3 * l + (s == 0 ? 0 : 2)) * M); et[3] = (unsigned long long)(shl + (s == 0 ? 0 : SHW_O2)); }
                } else if (s == 2) {
                    A = hs; Bt = wl + WL_IN; N = NP; K = D;
                    if (tid0()) { et[0] = 2ull; et[1] = (unsigned long long)R; et[2] = (unsigned long long)(rowss + (size_t)(3 * l + 1) * M); et[3] = (unsigned long long)(shl + SHW_O1); et[4] = (unsigned long long)(ARG_IN(9) + l * 512); }
                } else {
                    const int sub = (s == 1) ? 0 : (s == 4 ? 1 : 2);
                    const int nl = (sub == 2) ? l + 1 : l, nsub = (sub + 1) % 3;
                    const bool last = (nl == DEPTH);
                    A = (s == 4) ? mix : R; Bt = wl + (s == 1 ? WL_2A : (s == 4 ? WL_OUT : WL_2B)); N = D; K = (s == 4) ? D : FF;
                    if (l == 0 && s == 4) { int bo = blockIdx.x; asm volatile("" : "+s"(bo)); const int wv = __builtin_amdgcn_readfirstlane((int)(threadIdx.x >> 6)); shift_tables(tab, 1, bo * NWAVES + wv, G * NWAVES); }
                    if (tid0()) {
                        const float* gains = ARG_IN(4);
                        float* outp = ARG_OUT();
                        const bool first = (l == 0 && s == 1);
                        et[0] = 1ull; et[1] = (unsigned long long)ARG_IN(0); et[2] = (unsigned long long)(ws + WS_HF32); et[3] = (unsigned long long)hs;
                        et[4] = (unsigned long long)(modl + (3 * sub + 2) * D);
                        et[5] = (unsigned long long)(gains + (size_t)(3 * (last ? 0 : nl) + nsub) * D); et[6] = (unsigned long long)(mod + (size_t)(last ? 0 : nl) * 16 * NMOD + (3 * nsub + 1) * D);
                        et[7] = (unsigned long long)(rowss + (size_t)(3 * l + sub + 1) * M); et[8] = (unsigned long long)__float_as_uint((s == 4) ? 1.0f : 0.5f); et[9] = (first ? 1ull : 0ull) | (last ? 2ull : 0ull);
                        et[10] = (unsigned long long)(outp + (size_t)M * D / 2);
                    }
                }
                __syncthreads();
                pg8::Gemm g{A, Bt, M, N, K}; pg8::StaticOrder S; int bid_o = blockIdx.x; asm volatile("" : "+s"(bid_o)); S.init(M, N, G, bid_o);
                pg8::EpiAny E{(const LAS unsigned long long*)et};
                const int nrep_ = (s == 0 || s == 5) ? REP_UP : (s == 2 ? REP_WIN : ((s == 1 || s == 6) ? REP_DOWN : REP_WOUT));
                for (int rep_ = 0; rep_ < nrep_; ++rep_) {
                    if ((s == 1 || s == 4 || s == 6) && nrep_ > 1) { __syncthreads(); if (tid0()) { if (rep_ + 1 < nrep_) { et[20] = et[7]; et[21] = et[8]; et[7] = (unsigned long long)(ws + 3 * MiB); et[8] = 0ull; if (PROBE_MODE == 9) et[0] = 9ull; } else { et[7] = et[20]; et[8] = et[21]; et[0] = 1ull; } } __syncthreads(); }
                    pg8::gemm_phase<pg8::EpiAny, pg8::StaticOrder, true, true>(lds, g, S, E);
                }
            } else
#endif
            if (s == 3) {
#ifndef DIS_HGRN
                for (int rep_ = 0; rep_ < REP_M1; ++rep_) hgrn_prep(lds, R, ws, l, ARG_OUT(), rep_ == 0, rep_ == 0 ? 0 : PROBE_MODE);
#endif
            } else if (s == 7) {
                int bid_o = blockIdx.x; asm volatile("" : "+s"(bid_o)); const int bid = bid_o;
                const int nh = 64;
#ifndef DIS_HGRN
                if (bid < nh) for (int rep_ = 0; rep_ < REP_SCAN; ++rep_) hgrn_scan(lds, R, mix, ws, ARG_IN(9) + l * 512, ARG_OUT(), bid, rep_ == 0 ? 0 : PROBE_MODE);
                else
#endif
                {
                    const bf16_t* wspb = (const bf16_t*)(ws + WS_WSP) + (size_t)l * 4 * 128 * 128;
#ifndef DIS_GMLP
                    for (int rep_ = 0; rep_ < REP_GMLP; ++rep_)
                    gmlp_units(lds, R, mix, wspb, ARG_IN(10) + l * 512, ARG_IN(12) + l * 512, ARG_IN(13) + l * 512, bid - nh, G - nh);
#endif
                    if (l == 0) { const int wv = __builtin_amdgcn_readfirstlane((int)(threadIdx.x >> 6)); convert_weights(tab, lds, 1, (bid - nh) * NWAVES + wv, (G - nh) * NWAVES); }
                }
            }
        }
        if (ph + 1 < args.ph_hi) { if (args.ph_hi > N_PHASES) grid.sync(); else xcd_barrier(xbar); }
    }
}

#ifndef MK_PER_PHASE_LAUNCH
#define MK_PER_PHASE_LAUNCH 0
#endif
extern "C" void kernel_launch(void* const* d_in, const int* in_sizes, int n_in, void* d_out, int out_size, void* d_ws, size_t ws_size, hipStream_t stream) {
    static int grid = 0;
    if (grid == 0) {
        if (n_in != 18 || in_sizes[0] != M * D || out_size != M * D || ws_size < WS_END2) { fprintf(stderr, "kernel_launch: unexpected shapes (n_in %d, in0 %d, out %d, ws %zu)\n", n_in, n_in > 0 ? in_sizes[0] : -1, out_size, ws_size); grid = -1; return; }
        int dev = 0, cus = 0, per_cu = 0;
        hipGetDevice(&dev); hipDeviceGetAttribute(&cus, hipDeviceAttributeMultiprocessorCount, dev);
        if (hipFuncSetAttribute((const void*)fwd_megakernel, hipFuncAttributeMaxDynamicSharedMemorySize, LDS_BYTES) != hipSuccess) { fprintf(stderr, "kernel_launch: hipFuncSetAttribute failed\n"); grid = -1; return; }
        hipOccupancyMaxActiveBlocksPerMultiprocessor(&per_cu, (const void*)fwd_megakernel, NTHREADS, LDS_BYTES);
        (void)hipGetLastError();
        if (per_cu < 1) fprintf(stderr, "kernel_launch: occupancy query says %d blocks per CU\n", per_cu);
        grid = cus;
    }
    if (grid < 0) return;
    hipMemsetAsync((char*)d_ws, 0, WS_ZERO_BYTES, stream);
    Args a{};
    for (int i = 0; i < 18; ++i) a.in[i] = (const float*)d_in[i];
    a.out = (float*)d_out; a.ws = (unsigned char*)d_ws;
#if MK_PER_PHASE_LAUNCH
    for (int ph = 0; ph < N_PHASES; ++ph) { a.ph_lo = ph; a.ph_hi = ph + 1; hipLaunchKernelGGL(fwd_megakernel, dim3(grid), dim3(NTHREADS), LDS_BYTES, stream, a); }
#else
    a.ph_lo = 0; a.ph_hi = N_PHASES;
    void* kargs[] = {&a};
    hipError_t e = hipLaunchCooperativeKernel((const void*)fwd_megakernel, dim3(grid), dim3(NTHREADS), kargs, LDS_BYTES, stream);
    if (e != hipSuccess) fprintf(stderr, "cooperative launch failed: %s (grid %d)\n", hipGetErrorString(e), grid);
#endif
}
```
